# Optimizing an MI355X kernel written in HIP

```python
import jax, jax.numpy as jnp
from jax import lax
import numpy as np

D_MODEL = 1024
BATCH = 8
SEQ = 4096
DEPTH = 2

F32 = jnp.float32
EPS = 1e-6
MEM_LEN = 256
N_BRANCHES = 3
D_FF = 2816

RW_HEADS = 8
RW_HEAD_DIM = 64
RW_WIDTH = RW_HEADS * RW_HEAD_DIM
RW_DECAY_LORA = 64
RW_AAA_LORA = 64
RW_GATE_LORA = 160
RW_GN_EPS = 64e-5
RW_COLS = (RW_WIDTH, RW_WIDTH, RW_WIDTH, RW_DECAY_LORA, RW_AAA_LORA, RW_GATE_LORA)
RW_IN_COLS = sum(RW_COLS)

DIL_PATTERNS = ((128, 1), (512, 4), (2048, 16))
N_DIL = len(DIL_PATTERNS)
DIL_HEADS = 8
HEAD_DIM = 64
DIL_WIDTH = DIL_HEADS * HEAD_DIM
DIL_IN_COLS = 3 * N_DIL * DIL_WIDTH
ROPE_THETA = 500000.0
ROPE_DIM = HEAD_DIM // 4

RET_HEADS = 4
RET_QK_DIM = 64
RET_V_DIM = 128
RET_CHUNK = 128
RET_ROPE_BASE = 10000.0
RET_COLS = (RET_HEADS * RET_QK_DIM, RET_HEADS * RET_QK_DIM, RET_HEADS * RET_V_DIM, RET_HEADS * RET_V_DIM)
RET_IN_COLS = sum(RET_COLS)
RET_WIDTH = RET_HEADS * RET_V_DIM

GATE_IN_COLS = N_BRANCHES * D_MODEL
IN_COLS = RW_IN_COLS + DIL_IN_COLS + RET_IN_COLS + GATE_IN_COLS

XA_HEADS = 4
XA_HEAD_DIM = D_MODEL // XA_HEADS

kernel_name = 'hybrid_rwkv7_dilated_retention_block'


def split_cols(x, sizes):
    idx = [int(i) for i in np.cumsum(sizes)[:-1]]
    return jnp.split(x, idx, axis=-1)


def rms_norm(x, g, eps=EPS):
    xf = x.astype(F32)
    y = xf * lax.rsqrt(jnp.mean(xf * xf, axis=-1, keepdims=True) + eps)
    return (y * g.astype(F32)).astype(x.dtype)


def apply_rope(x, pos, rot_dim, base):
    half = rot_dim // 2
    inv_freq = base ** (-jnp.arange(half, dtype=F32) / half)
    ang = pos.astype(F32)[:, None] * inv_freq[None, :]
    cos = jnp.cos(ang)[None, :, None, :]
    sin = jnp.sin(ang)[None, :, None, :]
    xf = x.astype(F32)
    x1, x2, rest = xf[..., :half], xf[..., half:rot_dim], xf[..., rot_dim:]
    out = jnp.concatenate([x1 * cos - x2 * sin, x2 * cos + x1 * sin, rest], axis=-1)
    return out.astype(x.dtype)


def swiglu(x, w13, w2):
    a, b = jnp.split(x @ w13, 2, axis=-1)
    return (jax.nn.silu(a) * b) @ w2


def rwkv7_recurrence(r, decay, k, v, a, b):
    B, T, H, N = r.shape

    def step(S, inp):
        r_t, w_t, k_t, v_t, a_t, b_t = inp
        sa = jnp.einsum('bhvk,bhk->bhv', S, a_t)
        S = S * w_t[:, :, None, :] + sa[..., None] * b_t[:, :, None, :] + v_t[..., None] * k_t[:, :, None, :]
        return S, jnp.einsum('bhvk,bhk->bhv', S, r_t)

    xs = tuple(jnp.moveaxis(t, 1, 0) for t in (r, decay, k, v, a, b))
    _, y = lax.scan(step, jnp.zeros((B, H, N, N), F32), xs)
    return jnp.moveaxis(y, 0, 1)


def rwkv7_time_mix(p, mu, w0, w2, a0, a2, g2, k_k, k_a, r_k, ln_w, ln_b):
    B, T, _ = p.shape
    shifted = jnp.pad(p, ((0, 0), (1, 0), (0, 0)))[:, :-1]
    p = p + (shifted - p) * mu
    r, k, v, wd, ad, gd = split_cols(p, RW_COLS)
    w_log = -jax.nn.softplus(-(w0 + jnp.tanh(wd) @ w2).astype(F32)) - 0.5
    decay = jnp.exp(-jnp.exp(w_log))
    a = jax.nn.sigmoid((a0 + ad @ a2).astype(F32))
    g = jax.nn.sigmoid(gd) @ g2
    heads = lambda t: t.astype(F32).reshape(B, T, RW_HEADS, RW_HEAD_DIM)
    kk = heads(k * k_k)
    kk = kk / jnp.maximum(jnp.sqrt(jnp.sum(kk * kk, axis=-1, keepdims=True)), 1e-12)
    k = k.astype(F32) * (1.0 + (a - 1.0) * k_a.astype(F32))
    r_h, k_h, v_h, a_h, w_h = heads(r), heads(k), heads(v), heads(a), heads(decay)
    y = rwkv7_recurrence(r_h, w_h, k_h, v_h, -kk, kk * a_h)
    mean = jnp.mean(y, axis=-1, keepdims=True)
    var = jnp.mean(jnp.square(y - mean), axis=-1, keepdims=True)
    y = ((y - mean) * lax.rsqrt(var + RW_GN_EPS)).reshape(B, T, RW_WIDTH)
    y = y * ln_w.astype(F32) + ln_b.astype(F32)
    bonus = jnp.sum(r_h * k_h * r_k.astype(F32).reshape(RW_HEADS, RW_HEAD_DIM), axis=-1, keepdims=True) * v_h
    y = (y + bonus.reshape(B, T, RW_WIDTH)) * g.astype(F32)
    return y.astype(p.dtype)


def dilated_window_attention(q, k, v, window, dilation):
    B, T, H, Dh = q.shape
    L = window // dilation
    unit = L * dilation
    Tp = -(-T // unit) * unit
    M = Tp // dilation
    nb = M // L

    def to_blocks(t):
        t = jnp.pad(t, ((0, 0), (0, Tp - T), (0, 0), (0, 0)))
        t = t.reshape(B, M, dilation, H, Dh).transpose(0, 2, 1, 3, 4)
        return t.reshape(B, dilation, nb, L, H, Dh)

    def with_prev(t):
        prev = jnp.pad(t, ((0, 0), (0, 0), (1, 0), (0, 0), (0, 0), (0, 0)))[:, :, :-1]
        return jnp.concatenate([prev, t], axis=3)

    qb = to_blocks(q)
    kb = with_prev(to_blocks(k))
    vb = with_prev(to_blocks(v))
    s = jnp.einsum('brnqhd,brnkhd->brnhqk', qb, kb, preferred_element_type=F32) * (Dh ** -0.5)
    qi = jnp.arange(L)[:, None] + L
    ki = jnp.arange(2 * L)[None, :]
    dist = qi - ki
    band = (dist >= 0) & (dist <= L)
    valid = band[None] & ((jnp.arange(nb)[:, None, None] > 0) | (ki[None] >= L))
    s = jnp.where(valid[None, None, :, None], s, -jnp.inf)
    m = jnp.max(s, axis=-1, keepdims=True)
    e = jnp.exp(s - m)
    den = jnp.sum(e, axis=-1, keepdims=True)
    o = jnp.einsum('brnhqk,brnkhd->brnqhd', e / den, vb.astype(F32))
    lse = (m + jnp.log(den))[..., 0]
    o = o.reshape(B, dilation, M, H, Dh).transpose(0, 2, 1, 3, 4).reshape(B, Tp, H, Dh)[:, :T]
    lse = lse.transpose(0, 1, 2, 4, 3).reshape(B, dilation, M, H).transpose(0, 2, 1, 3).reshape(B, Tp, H)[:, :T]
    return o, lse


def dilated_attention_mixture(p, q_norm, k_norm, pos):
    B, T, _ = p.shape
    cols = split_cols(p, (DIL_WIDTH,) * (3 * N_DIL))
    outs, lses = [], []
    for g, (window, dilation) in enumerate(DIL_PATTERNS):
        q, k, v = (c.reshape(B, T, DIL_HEADS, HEAD_DIM) for c in cols[3 * g:3 * g + 3])
        q = apply_rope(rms_norm(q, q_norm[g]), pos, ROPE_DIM, ROPE_THETA)
        k = apply_rope(rms_norm(k, k_norm[g]), pos, ROPE_DIM, ROPE_THETA)
        o, lse = dilated_window_attention(q, k, v, window, dilation)
        outs.append(o)
        lses.append(lse)
    weights = jax.nn.softmax(jnp.stack(lses), axis=0)
    o = jnp.einsum('gbth,gbthd->bthd', weights, jnp.stack(outs))
    return o.reshape(B, T, DIL_WIDTH).astype(p.dtype)


def retention_chunkwise(q, k, v, log_gamma):
    B, T, H, dk = q.shape
    dv = v.shape[-1]
    C = RET_CHUNK
    Tp = -(-T // C) * C
    nc = Tp // C
    chunk = lambda t: jnp.pad(t, ((0, 0), (0, Tp - T), (0, 0), (0, 0))).reshape(B, nc, C, H, t.shape[-1])
    qc, kc, vc = chunk(q), chunk(k), chunk(v)
    j = jnp.arange(C, dtype=F32)
    diff = j[:, None] - j[None, :]
    decay_in = jnp.where(diff >= 0, jnp.exp(log_gamma[:, None, None] * jnp.maximum(diff, 0.0)), 0.0)
    s = jnp.einsum('bcihd,bcjhd->bchij', qc, kc) * decay_in
    inner = jnp.einsum('bchij,bcjhe->bcihe', s, vc)
    k_dec = jnp.exp(log_gamma[None, :] * (C - 1 - j)[:, None])
    kv = jnp.einsum('bcjhd,jh,bcjhe->bchde', kc, k_dec, vc)
    gamma_c = jnp.exp(log_gamma * C)[None, :, None, None]

    def step(S, kv_c):
        return gamma_c * S + kv_c, S

    _, S_prev = lax.scan(step, jnp.zeros((B, H, dk, dv), F32), jnp.moveaxis(kv, 1, 0))
    S_prev = jnp.moveaxis(S_prev, 0, 1)
    q_dec = jnp.exp(log_gamma[None, :] * (j + 1.0)[:, None])
    cross = jnp.einsum('bcihd,ih,bchde->bcihe', qc, q_dec, S_prev)
    return (inner + cross).reshape(B, Tp, H, dv)[:, :T]


def multiscale_retention(p, gain, pos):
    B, T, _ = p.shape
    q, k, v, g = split_cols(p, RET_COLS)
    q = apply_rope(q.reshape(B, T, RET_HEADS, RET_QK_DIM), pos, RET_QK_DIM, RET_ROPE_BASE)
    k = apply_rope(k.reshape(B, T, RET_HEADS, RET_QK_DIM), pos, RET_QK_DIM, RET_ROPE_BASE)
    v = v.reshape(B, T, RET_HEADS, RET_V_DIM)
    log_gamma = jnp.log(1.0 - 2.0 ** (-5.0 - jnp.arange(RET_HEADS, dtype=F32)))
    y = retention_chunkwise(q.astype(F32), k.astype(F32) * (RET_QK_DIM ** -0.5), v.astype(F32), log_gamma)
    y = rms_norm(y, gain.reshape(RET_HEADS, RET_V_DIM))
    return jax.nn.silu(g) * y.reshape(B, T, RET_WIDTH).astype(g.dtype)


def hybrid_mixer(u, w_in, rw_mu, rw_w0, rw_w2, rw_a0, rw_a2, rw_g2, rw_k_k, rw_k_a, rw_r_k,
                 rw_ln_w, rw_ln_b, dil_q_norm, dil_k_norm, ret_norm,
                 w_branch_rwkv, w_branch_dil, w_branch_ret, w_out):
    B, T, _ = u.shape
    pos = jnp.arange(T)
    proj = u @ w_in
    p_rw, p_dil, p_ret, p_gate = split_cols(proj, (RW_IN_COLS, DIL_IN_COLS, RET_IN_COLS, GATE_IN_COLS))
    y_a = rwkv7_time_mix(p_rw, rw_mu, rw_w0, rw_w2, rw_a0, rw_a2, rw_g2, rw_k_k, rw_k_a, rw_r_k, rw_ln_w, rw_ln_b)
    y_b = dilated_attention_mixture(p_dil, dil_q_norm, dil_k_norm, pos)
    y_c = multiscale_retention(p_ret, ret_norm, pos)
    gates = jax.nn.sigmoid(p_gate.reshape(B, T, N_BRANCHES, D_MODEL))
    merged = (gates[:, :, 0] * (y_a @ w_branch_rwkv)
              + gates[:, :, 1] * (y_b @ w_branch_dil)
              + gates[:, :, 2] * (y_c @ w_branch_ret))
    return merged @ w_out


def memory_cross_attention(hn, mn, wq, wkv, q_norm, k_norm, wo):
    B, T, _ = hn.shape
    Ml = mn.shape[1]
    q = (hn @ wq).reshape(B, T, XA_HEADS, XA_HEAD_DIM)
    k, v = jnp.split(mn @ wkv, 2, axis=-1)
    k = k.reshape(B, Ml, XA_HEADS, XA_HEAD_DIM)
    v = v.reshape(B, Ml, XA_HEADS, XA_HEAD_DIM)
    q = rms_norm(q, q_norm)
    k = rms_norm(k, k_norm)
    s = jnp.einsum('bthd,bmhd->bhtm', q, k, preferred_element_type=F32) * (XA_HEAD_DIM ** -0.5)
    pr = jax.nn.softmax(s, axis=-1)
    o = jnp.einsum('bhtm,bmhd->bthd', pr.astype(v.dtype), v)
    return o.reshape(B, T, D_MODEL) @ wo


def setup_inputs(seed: int = 0) -> dict:
    key = jax.random.key(seed)
    ks = iter(list(jax.random.split(key, 64)))
    L, D = DEPTH, D_MODEL

    def nrm(shape, scale):
        return jax.random.normal(next(ks), shape, F32) * scale

    def gain(shape):
        return 1.0 + 0.02 * jax.random.normal(next(ks), shape, F32)

    def unif(shape, lo, hi):
        return jax.random.uniform(next(ks), shape, F32, lo, hi)

    return {
        'x': nrm((BATCH, SEQ, D), 1.0),
        'mem': nrm((BATCH, MEM_LEN, D), 1.0),
        'norm_ffn1': gain((L, D)),
        'ffn1_w13': nrm((L, D, 2 * D_FF), D ** -0.5),
        'ffn1_w2': nrm((L, D_FF, D), D_FF ** -0.5),
        'norm_mix': gain((L, D)),
        'w_in': nrm((L, D, IN_COLS), D ** -0.5),
        'rw_mu': unif((L, RW_IN_COLS), 0.0, 1.0),
        'rw_w0': unif((L, RW_WIDTH), -6.0, 0.0),
        'rw_w2': nrm((L, RW_DECAY_LORA, RW_WIDTH), 0.5 * RW_DECAY_LORA ** -0.5),
        'rw_a0': nrm((L, RW_WIDTH), 0.1),
        'rw_a2': nrm((L, RW_AAA_LORA, RW_WIDTH), 0.5 * RW_AAA_LORA ** -0.5),
        'rw_g2': nrm((L, RW_GATE_LORA, RW_WIDTH), RW_GATE_LORA ** -0.5),
        'rw_k_k': 0.85 + 0.02 * jax.random.normal(next(ks), (L, RW_WIDTH), F32),
        'rw_k_a': gain((L, RW_WIDTH)),
        'rw_r_k': nrm((L, RW_WIDTH), 0.1),
        'rw_ln_w': gain((L, RW_WIDTH)),
        'rw_ln_b': nrm((L, RW_WIDTH), 0.02),
        'dil_q_norm': gain((L, N_DIL, HEAD_DIM)),
        'dil_k_norm': gain((L, N_DIL, HEAD_DIM)),
        'ret_norm': gain((L, RET_WIDTH)),
        'w_branch_rwkv': nrm((L, RW_WIDTH, D), RW_WIDTH ** -0.5),
        'w_branch_dil': nrm((L, DIL_WIDTH, D), DIL_WIDTH ** -0.5),
        'w_branch_ret': nrm((L, RET_WIDTH, D), RET_WIDTH ** -0.5),
        'w_out': nrm((L, D, D), D ** -0.5),
        'norm_xattn': gain((L, D)),
        'norm_mem': gain((L, D)),
        'xa_wq': nrm((L, D, D), D ** -0.5),
        'xa_wkv': nrm((L, D, 2 * D), D ** -0.5),
        'xa_q_norm': gain((L, XA_HEAD_DIM)),
        'xa_k_norm': gain((L, XA_HEAD_DIM)),
        'xa_wo': nrm((L, D, D), D ** -0.5),
        'norm_ffn2': gain((L, D)),
        'ffn2_w13': nrm((L, D, 2 * D_FF), D ** -0.5),
        'ffn2_w2': nrm((L, D_FF, D), D_FF ** -0.5),
    }


def reference(x, mem, norm_ffn1, ffn1_w13, ffn1_w2, norm_mix, w_in, rw_mu, rw_w0, rw_w2, rw_a0, rw_a2,
              rw_g2, rw_k_k, rw_k_a, rw_r_k, rw_ln_w, rw_ln_b, dil_q_norm, dil_k_norm, ret_norm,
              w_branch_rwkv, w_branch_dil, w_branch_ret, w_out, norm_xattn, norm_mem, xa_wq, xa_wkv,
              xa_q_norm, xa_k_norm, xa_wo, norm_ffn2, ffn2_w13, ffn2_w2):
    h = x
    for l in range(DEPTH):
        h = h + 0.5 * swiglu(rms_norm(h, norm_ffn1[l]), ffn1_w13[l], ffn1_w2[l])
        h = h + hybrid_mixer(rms_norm(h, norm_mix[l]), w_in[l], rw_mu[l], rw_w0[l], rw_w2[l], rw_a0[l],
                             rw_a2[l], rw_g2[l], rw_k_k[l], rw_k_a[l], rw_r_k[l], rw_ln_w[l], rw_ln_b[l],
                             dil_q_norm[l], dil_k_norm[l], ret_norm[l],
                             w_branch_rwkv[l], w_branch_dil[l], w_branch_ret[l], w_out[l])
        h = h + memory_cross_attention(rms_norm(h, norm_xattn[l]), rms_norm(mem, norm_mem[l]),
                                       xa_wq[l], xa_wkv[l], xa_q_norm[l], xa_k_norm[l], xa_wo[l])
        h = h + 0.5 * swiglu(rms_norm(h, norm_ffn2[l]), ffn2_w13[l], ffn2_w2[l])
    return h
```

```cpp
#include <hip/hip_runtime.h>
#include <hip/hip_cooperative_groups.h>
#include <cstdio>
#include <cstdint>
namespace cg = cooperative_groups;
namespace pg8 {
#define PG8_LAS __attribute__((address_space(3)))
typedef unsigned short bf16_t;
typedef short bf16x8 __attribute__((ext_vector_type(8)));
typedef float f32x4 __attribute__((ext_vector_type(4)));
typedef unsigned u32x4 __attribute__((ext_vector_type(4)));
constexpr int BM = 256, BK = 64, HALF = 128, HTB = HALF * BK * 2  , STAGE_BYTES = 8 * HTB, NXCD = 8, WGM = 8;

__host__ __device__ __forceinline__ int lds_byte(int r, int c) { const int st = (r >> 4) * 2 + (c >> 5), rr = r & 15, cc = c & 31, ob = rr * 64 + cc * 2; return st * 1024 + (ob ^ (((ob >> 9) & 1) << 5)); }
__host__ __device__ __forceinline__ void stage_rc(int b, int& R, int& C) { const int st = b / 1024, sb = b % 1024, swz = sb ^ (((sb >> 9) & 1) << 5); R = (st >> 1) * 16 + swz / 64; C = (st & 1) * 32 + (swz % 64) / 2; }
__host__ __device__ __forceinline__ int perm32(int rho) { const int n = rho >> 4, i = rho & 15; return 8 * (i >> 2) + 4 * n + (i & 3); }

struct Unit { int pm, pn; };
struct Gemm { const bf16_t* A; const bf16_t* Bt; int M, N, K; };

struct StaticOrder {
    int nM, nN, nwg, G, c;
    __host__ __device__ void init(int M, int N, int G_, int c_) { nM = M / BM; nN = N / BM; nwg = nM * nN; G = G_; c = c_; }
    __host__ __device__ bool next(int i, Unit& u) const {
        const long L = (long)i * G + c; if (L >= nwg) return false;
        int wgid = (int)L; { const int q = nwg / NXCD, r = nwg % NXCD, xcd = wgid % NXCD, off = wgid / NXCD; wgid = (xcd < r ? xcd * (q + 1) : r * (q + 1) + (xcd - r) * q) + off; }
        const int nig = WGM * nN, gid = wgid / nig, fm = gid * WGM, gsz = (nM - fm) < WGM ? (nM - fm) : WGM;
        u.pm = fm + ((wgid % nig) % gsz); u.pn = (wgid % nig) / gsz; return true;
    }
    __device__ __forceinline__ void a_ready(const Unit&) const {}
    __device__ __forceinline__ void done(const Unit&) const {}
};

__device__ __forceinline__ unsigned cvt_pk_bf16(float lo, float hi) { unsigned r; asm volatile("s_nop 0\n\tv_cvt_pk_bf16_f32 %0, %1, %2" : "=v"(r) : "v"(lo), "v"(hi)); return r; }
typedef float f32x2 __attribute__((ext_vector_type(2)));
template <class Epi, class Sched, bool ALIGN_EPI = false, bool SP2 = false>
__device__ __forceinline__ void gemm_phase(PG8_LAS unsigned char* lds, const Gemm g, const Sched& S, const Epi& E) {
    int tid_ = threadIdx.x; asm volatile("" : "+v"(tid_));
    const int tid = tid_, wid = __builtin_amdgcn_readfirstlane(tid >> 6), lane = tid & 63, wr = wid >> 2, wc = wid & 3, fr = lane & 15, fq = lane >> 4;
    const int K = g.K, nt = K / BK;
    unsigned voffA[2], voffB[2];
#pragma unroll
    for (int i = 0; i < 2; ++i) { int R, C; stage_rc(tid * 16 + i * 8192, R, C); const int Rb = Epi::PERM ? ((R & ~31) + perm32(R & 31)) : R;
        voffA[i] = (unsigned)(R * K + C) * 2u; voffB[i] = (unsigned)(Rb * K + C) * 2u; }
    const size_t kstep = (size_t)(BK * 2);
    const size_t hstep = (size_t)HALF * K * 2;
    const size_t tstep = 2 * hstep;
    const unsigned ldsw = (unsigned)wid * 1024u;
    const int aoff = lds_byte(wr * 64 + fr, fq * 8), boff = lds_byte(wc * 32 + fr, fq * 8);
#define PG8_SA(b, h) (((b) * 2 + (h)) * HTB)
#define PG8_SB(b, h) ((4 + (b) * 2 + (h)) * HTB)
#define PG8_STAGE(bufoff, gbase, voff) do { _Pragma("unroll") for (int _i = 0; _i < 2; ++_i) \
        __builtin_amdgcn_global_load_lds((const unsigned*)((const char*)(gbase) + (voff)[_i]), (PG8_LAS unsigned*)(lds + (bufoff) + ldsw + _i * 8192), 16, 0, 0); } while (0)
#define PG8_LDA(dst, b, h) do { _Pragma("unroll") for (int m = 0; m < 4; ++m) _Pragma("unroll") for (int k = 0; k < 2; ++k) dst[m][k] = *(const PG8_LAS bf16x8*)(lds + PG8_SA(b, h) + aoff + m * 2048 + k * 1024); } while (0)
#define PG8_LDB(dst, b, h) do { _Pragma("unroll") for (int n = 0; n < 2; ++n) _Pragma("unroll") for (int k = 0; k < 2; ++k) dst[n][k] = *(const PG8_LAS bf16x8*)(lds + PG8_SB(b, h) + boff + n * 2048 + k * 1024); } while (0)
#define PG8_MMA(ai, bj, At, Bt) do { __builtin_amdgcn_s_setprio(1); _Pragma("unroll") for (int m = 0; m < 4; ++m) _Pragma("unroll") for (int n = 0; n < 2; ++n) _Pragma("unroll") for (int k = 0; k < 2; ++k) \
        acc[ai][bj][m][n] = __builtin_amdgcn_mfma_f32_16x16x32_bf16(Bt[n][k], At[m][k], acc[ai][bj][m][n], 0, 0, 0); __builtin_amdgcn_s_setprio(0); } while (0)
#define PG8_WAIT_V(n) asm volatile("s_waitcnt vmcnt(" #n ")" ::: "memory")
#define PG8_WAIT_L(n) asm volatile("s_waitcnt lgkmcnt(" #n ")" ::: "memory")
#define PG8_BAR __builtin_amdgcn_s_barrier()
#define PG8_SCHED __builtin_amdgcn_sched_barrier(0)
    Unit cur, nxt; int ui = 0;
    if (!S.next(0, cur)) return;
    f32x4 acc[2][2][4][2];
#pragma unroll
    for (int a = 0; a < 2; ++a)
#pragma unroll
        for (int b = 0; b < 2; ++b)
#pragma unroll
            for (int m = 0; m < 4; ++m)
#pragma unroll
                for (int n = 0; n < 2; ++n) acc[a][b][m][n] = (f32x4){0.f, 0.f, 0.f, 0.f};
    bf16x8 At[4][2], B0[2][2], B1[2][2];
    const char* cA = (const char*)g.A + (size_t)cur.pm * tstep; const char* cB = (const char*)g.Bt + (size_t)cur.pn * tstep;
    S.a_ready(cur);
    if constexpr (SP2) {
        PG8_STAGE(PG8_SB(0, 0), cB, voffB); PG8_STAGE(PG8_SB(0, 1), cB + hstep, voffB); PG8_STAGE(PG8_SA(0, 0), cA, voffA); PG8_STAGE(PG8_SA(0, 1), cA + hstep, voffA);
        if (wr == 1) PG8_BAR;
        PG8_WAIT_V(2); PG8_BAR;
        PG8_STAGE(PG8_SB(1, 0), cB + kstep, voffB); PG8_STAGE(PG8_SA(1, 0), cA + kstep, voffA); PG8_STAGE(PG8_SB(1, 1), cB + hstep + kstep, voffB);
        PG8_WAIT_V(6); PG8_BAR;
    } else {
        PG8_STAGE(PG8_SB(0, 0), cB, voffB); PG8_STAGE(PG8_SA(0, 0), cA, voffA); PG8_STAGE(PG8_SB(0, 1), cB + hstep, voffB); PG8_STAGE(PG8_SA(0, 1), cA + hstep, voffA);
        if (wr == 1) PG8_BAR;
        PG8_WAIT_V(4); PG8_BAR;
        PG8_STAGE(PG8_SB(1, 0), cB + kstep, voffB); PG8_STAGE(PG8_SA(1, 0), cA + kstep, voffA); PG8_STAGE(PG8_SB(1, 1), cB + hstep + kstep, voffB);
        PG8_WAIT_V(6); PG8_BAR;
    }
    for (;;) {
        const bool has_next = S.next(ui + 1, nxt);
        const char* nA = has_next ? (const char*)g.A + (size_t)nxt.pm * tstep : cA; const char* nB = has_next ? (const char*)g.Bt + (size_t)nxt.pn * tstep : cB;
#pragma unroll 1
        for (int t = 0; t < nt; t += 2) {
            const bool last = (t == nt - 2);
            const char* a1 = cA + (size_t)(t + 1) * kstep;
            const char* a2 = last ? nA : cA + (size_t)(t + 2) * kstep; const char* b2 = last ? nB : cB + (size_t)(t + 2) * kstep;
            const char* a3 = a2 + kstep; const char* b3 = b2 + kstep;
            if (last && has_next) S.a_ready(nxt);
            if constexpr (SP2) {
            PG8_LDB(B0, 0, 0); PG8_LDB(B1, 0, 1); PG8_SCHED; PG8_LDA(At, 0, 0); PG8_STAGE(PG8_SA(1, 1), a1 + hstep, voffA);
            PG8_WAIT_V(8); PG8_WAIT_L(0); PG8_BAR; PG8_MMA(0, 0, At, B0); PG8_MMA(0, 1, At, B1); PG8_BAR; PG8_SCHED;
            PG8_LDA(At, 0, 1); PG8_STAGE(PG8_SB(0, 0), b2, voffB); PG8_STAGE(PG8_SB(0, 1), b2 + hstep, voffB); PG8_STAGE(PG8_SA(0, 0), a2, voffA);
            PG8_WAIT_V(8); PG8_WAIT_L(0); PG8_BAR; PG8_MMA(1, 0, At, B0); PG8_MMA(1, 1, At, B1); PG8_BAR; PG8_SCHED;
            PG8_LDB(B0, 1, 0); PG8_LDB(B1, 1, 1); PG8_SCHED; PG8_LDA(At, 1, 0); PG8_STAGE(PG8_SA(0, 1), a2 + hstep, voffA);
            PG8_WAIT_V(8); PG8_WAIT_L(0); PG8_BAR; PG8_MMA(0, 0, At, B0); PG8_MMA(0, 1, At, B1); PG8_BAR; PG8_SCHED;
            PG8_LDA(At, 1, 1); PG8_STAGE(PG8_SB(1, 0), b3, voffB); PG8_STAGE(PG8_SB(1, 1), b3 + hstep, voffB); PG8_STAGE(PG8_SA(1, 0), a3, voffA);
            PG8_WAIT_V(8); PG8_WAIT_L(0); PG8_BAR; PG8_MMA(1, 0, At, B0); PG8_MMA(1, 1, At, B1); PG8_BAR; PG8_SCHED;
            } else {
            PG8_LDB(B0, 0, 0); PG8_SCHED; PG8_LDA(At, 0, 0); PG8_STAGE(PG8_SA(1, 1), a1 + hstep, voffA);
            PG8_WAIT_L(8); PG8_BAR; PG8_WAIT_L(0); PG8_MMA(0, 0, At, B0); PG8_BAR; PG8_SCHED;
            PG8_LDB(B1, 0, 1); PG8_STAGE(PG8_SB(0, 0), b2, voffB);
            PG8_BAR; PG8_WAIT_L(0); PG8_MMA(0, 1, At, B1); PG8_BAR;
            PG8_LDA(At, 0, 1); PG8_STAGE(PG8_SA(0, 0), a2, voffA);
            PG8_BAR; PG8_WAIT_L(0); PG8_MMA(1, 0, At, B0); PG8_BAR; PG8_SCHED;
            PG8_STAGE(PG8_SB(0, 1), b2 + hstep, voffB);
            PG8_WAIT_V(6); PG8_BAR; PG8_MMA(1, 1, At, B1); PG8_BAR;
            PG8_LDB(B0, 1, 0); PG8_SCHED; PG8_LDA(At, 1, 0); PG8_STAGE(PG8_SA(0, 1), a2 + hstep, voffA);
            PG8_WAIT_L(8); PG8_BAR; PG8_WAIT_L(0); PG8_MMA(0, 0, At, B0); PG8_BAR; PG8_SCHED;
            PG8_LDB(B1, 1, 1); PG8_STAGE(PG8_SB(1, 0), b3, voffB);
            PG8_BAR; PG8_WAIT_L(0); PG8_MMA(0, 1, At, B1); PG8_BAR;
            PG8_LDA(At, 1, 1); PG8_STAGE(PG8_SA(1, 0), a3, voffA);
            PG8_BAR; PG8_WAIT_L(0); PG8_MMA(1, 0, At, B0); PG8_BAR; PG8_SCHED;
            PG8_STAGE(PG8_SB(1, 1), b3 + hstep, voffB);
            PG8_WAIT_V(6); PG8_BAR; PG8_MMA(1, 1, At, B1); PG8_BAR;
            }
        }
        if constexpr (ALIGN_EPI) { if (wr == 0) PG8_BAR; }
        if constexpr (!Epi::AFTER_DRAIN) { E(acc, cur, wr, wc, fr, fq); S.done(cur); }
        if (!has_next) break;
#pragma unroll
        for (int a = 0; a < 2; ++a)
#pragma unroll
            for (int b = 0; b < 2; ++b)
#pragma unroll
                for (int m = 0; m < 4; ++m)
#pragma unroll
                    for (int n = 0; n < 2; ++n) acc[a][b][m][n] = (f32x4){0.f, 0.f, 0.f, 0.f};
        cur = nxt; cA = nA; cB = nB; ++ui;
        if constexpr (ALIGN_EPI) { if (wr == 1) PG8_BAR; }
    }
    PG8_WAIT_V(0);
    if constexpr (!ALIGN_EPI) { if (wr == 0) PG8_BAR; }
    PG8_BAR;
    if constexpr (Epi::AFTER_DRAIN) { E.fused(acc, cur, wr, wc, fr, fq, lds, wid, lane); S.done(cur); }
#undef PG8_SA
#undef PG8_SB
#undef PG8_STAGE
#undef PG8_LDA
#undef PG8_LDB
#undef PG8_MMA
#undef PG8_WAIT_V
#undef PG8_WAIT_L
#undef PG8_BAR
#undef PG8_SCHED
}
}

#define LAS __attribute__((address_space(3)))
typedef unsigned short bf16_t;
typedef float f32x4 __attribute__((ext_vector_type(4)));
typedef float f32x2v __attribute__((ext_vector_type(2)));
typedef unsigned u32x4 __attribute__((ext_vector_type(4)));
typedef unsigned u32x2 __attribute__((ext_vector_type(2)));

constexpr int NT = 32768, DM = 1024, SEQ = 4096, DFF = 2816;
constexpr int CH = 16384;
constexpr size_t MiB = 1u << 20;
constexpr int LDS_BYTES = 147456;

constexpr size_t WS_TAB = 1 * MiB;
constexpr size_t WS_WB = 4 * MiB;
constexpr size_t WS_KV = 70 * MiB;
constexpr size_t WS_U = 86 * MiB;
constexpr size_t WS_T = 150 * MiB;
constexpr size_t WS_END = 512 * MiB;
constexpr size_t WO_W13A = 0, WO_W2A = WO_W13A + 5632 * 1024, WO_W13B = WO_W2A + 1024 * 2816, WO_W2B = WO_W13B + 5632 * 1024,
                 WO_RW = WO_W2B + 1024 * 2816, WO_DR = WO_RW + 2048 * 1024, WO_G = WO_DR + 6144 * 1024, WO_LORA = WO_G + 3072 * 1024,
                 WO_BR = WO_LORA + 1536 * 384, WO_OUT = WO_BR + 3 * 1024 * 512, WO_Q = WO_OUT + 1024 * 1024, WO_O = WO_Q + 1024 * 1024, WO_ENDW = WO_O + 1024 * 1024;
static_assert(WO_ENDW * 2 <= 66 * MiB, "weights fit");

__device__ __forceinline__ float bf_lo(unsigned u) { return __uint_as_float(u << 16); }
__device__ __forceinline__ float bf_hi(unsigned u) { return __uint_as_float(u & 0xffff0000u); }
__device__ __forceinline__ float bf2f(bf16_t h) { return __uint_as_float((unsigned)h << 16); }
__device__ __forceinline__ unsigned pk2(float lo, float hi) { unsigned r; asm volatile("s_nop 0\n\tv_cvt_pk_bf16_f32 %0, %1, %2" : "=v"(r) : "v"(lo), "v"(hi)); return r; }
__device__ __forceinline__ unsigned f2bf(float f) { return pk2(f, 0.f) & 0xffffu; }
__device__ __forceinline__ float wave_sum(float v) {
#pragma unroll
    for (int o = 1; o < 64; o <<= 1) v += __shfl_xor(v, o);
    return v;
}
template <int CTRL> __device__ __forceinline__ float dpp_f(float v) { return __int_as_float(__builtin_amdgcn_update_dpp(0, __float_as_int(v), CTRL, 0xf, 0xf, true)); }
__device__ __forceinline__ float quad_sum(float v) { v += dpp_f<0xB1>(v); v += dpp_f<0x4E>(v); return v; }
__device__ __forceinline__ float wave_sum_fast(float v) {
    v = quad_sum(v); v += dpp_f<0x141>(v); v += dpp_f<0x140>(v);
    const float a = __int_as_float(__builtin_amdgcn_readlane(__float_as_int(v), 0)), b = __int_as_float(__builtin_amdgcn_readlane(__float_as_int(v), 16)),
                c = __int_as_float(__builtin_amdgcn_readlane(__float_as_int(v), 32)), d = __int_as_float(__builtin_amdgcn_readlane(__float_as_int(v), 48));
    return (a + b) + (c + d);
}
__device__ __forceinline__ float sigmoidf_(float x) { return __builtin_amdgcn_rcpf(1.0f + __expf(-x)); }
__device__ __forceinline__ void ld8(const bf16_t* p, float* f) { const u32x4 u = *(const u32x4*)p;
    f[0] = bf_lo(u.x); f[1] = bf_hi(u.x); f[2] = bf_lo(u.y); f[3] = bf_hi(u.y); f[4] = bf_lo(u.z); f[5] = bf_hi(u.z); f[6] = bf_lo(u.w); f[7] = bf_hi(u.w); }
#define LDS_WAIT() asm volatile("s_waitcnt lgkmcnt(0)" ::: "memory")
__device__ __forceinline__ int otid() { int t = threadIdx.x; asm volatile("" : "+v"(t)); return t; }

using pg8::Unit;
struct EpiStore {
    static constexpr bool PERM = true, AFTER_DRAIN = false;
    bf16_t* O; int ldc; int nvalid; int split_cols; size_t split_stride;
    __device__ __forceinline__ void operator()(const f32x4 (&acc)[2][2][4][2], const Unit& u, int wr, int wc, int fr, int fq) const {
        const int row0 = u.pm * 256 + wr * 64 + fr;
#pragma unroll
        for (int bj = 0; bj < 2; ++bj) {
            int c = u.pn * 256 + bj * 128 + wc * 32 + 8 * fq; if (c >= nvalid) continue;
            bf16_t* base = O; if (split_cols) { const int t = c / split_cols; base += (size_t)t * split_stride; c -= t * split_cols; }
#pragma unroll
            for (int ai = 0; ai < 2; ++ai)
#pragma unroll
                for (int m = 0; m < 4; ++m) { const f32x4 v0 = acc[ai][bj][m][0], v1 = acc[ai][bj][m][1]; u32x4 w;
                    w.x = pg8::cvt_pk_bf16(v0[0], v0[1]); w.y = pg8::cvt_pk_bf16(v0[2], v0[3]); w.z = pg8::cvt_pk_bf16(v1[0], v1[1]); w.w = pg8::cvt_pk_bf16(v1[2], v1[3]);
                    *(u32x4*)(base + (size_t)(row0 + ai * 128 + m * 16) * ldc + c) = w; }
        }
    }
};
struct EpiSwiglu {
    static constexpr bool PERM = true, AFTER_DRAIN = false;
    bf16_t* O;
    __device__ __forceinline__ void operator()(const f32x4 (&acc)[2][2][4][2], const Unit& u, int wr, int wc, int fr, int fq) const {
        const int row0 = u.pm * 256 + wr * 64 + fr, c = u.pn * 128 + wc * 32 + 8 * fq;
#pragma unroll
        for (int ai = 0; ai < 2; ++ai)
#pragma unroll
            for (int m = 0; m < 4; ++m) { float o[8];
#pragma unroll
                for (int n = 0; n < 2; ++n)
#pragma unroll
                    for (int j = 0; j < 4; ++j) { const float a = acc[ai][0][m][n][j], b = acc[ai][1][m][n][j]; o[n * 4 + j] = a * sigmoidf_(a) * b; }
                u32x4 w; w.x = pg8::cvt_pk_bf16(o[0], o[1]); w.y = pg8::cvt_pk_bf16(o[2], o[3]); w.z = pg8::cvt_pk_bf16(o[4], o[5]); w.w = pg8::cvt_pk_bf16(o[6], o[7]);
                *(u32x4*)(O + (size_t)(row0 + ai * 128 + m * 16) * DFF + c) = w; }
    }
};
struct EpiResid {
    static constexpr bool PERM = true, AFTER_DRAIN = false;
    const float* base; float* out; float scale;
    __device__ __forceinline__ void operator()(const f32x4 (&acc)[2][2][4][2], const Unit& u, int wr, int wc, int fr, int fq) const {
        const int row0 = u.pm * 256 + wr * 64 + fr;
#pragma unroll
        for (int ai = 0; ai < 2; ++ai)
#pragma unroll
            for (int m = 0; m < 4; ++m)
#pragma unroll
                for (int bj = 0; bj < 2; ++bj) { const size_t off = (size_t)(row0 + ai * 128 + m * 16) * DM + u.pn * 256 + bj * 128 + wc * 32 + 8 * fq;
                    const f32x4 b0 = *(const f32x4*)(base + off), b1 = *(const f32x4*)(base + off + 4);
                    *(f32x4*)(out + off) = b0 + acc[ai][bj][m][0] * scale; *(f32x4*)(out + off + 4) = b1 + acc[ai][bj][m][1] * scale; }
    }
};
struct EpiF32 {
    static constexpr bool PERM = true, AFTER_DRAIN = false;
    float* out; int ldc;
    __device__ __forceinline__ void operator()(const f32x4 (&acc)[2][2][4][2], const Unit& u, int wr, int wc, int fr, int fq) const {
        const int row0 = u.pm * 256 + wr * 64 + fr;
#pragma unroll
        for (int ai = 0; ai < 2; ++ai)
#pragma unroll
            for (int m = 0; m < 4; ++m)
#pragma unroll
                for (int bj = 0; bj < 2; ++bj) { const size_t off = (size_t)(row0 + ai * 128 + m * 16) * ldc + u.pn * 256 + bj * 128 + wc * 32 + 8 * fq;
                    *(f32x4*)(out + off) = acc[ai][bj][m][0]; *(f32x4*)(out + off + 4) = acc[ai][bj][m][1]; }
    }
};
template <int KIND> struct EpiLora {
    static constexpr bool PERM = true, AFTER_DRAIN = false;
    float* decay; bf16_t* ab; bf16_t* gb; const float* w0; const float* a0;
    __device__ __forceinline__ void operator()(const f32x4 (&acc)[2][2][4][2], const Unit& u, int wr, int wc, int fr, int fq) const {
        const int row0 = u.pm * 256 + wr * 64 + fr;
#pragma unroll
        for (int bj = 0; bj < 2; ++bj) {
            const int c = u.pn * 256 + bj * 128 + wc * 32 + 8 * fq;
            f32x4 b0 = {0.f, 0.f, 0.f, 0.f}, b1 = b0;
            if (KIND == 0) { b0 = *(const f32x4*)(w0 + c); b1 = *(const f32x4*)(w0 + c + 4); }
            if (KIND == 1) { b0 = *(const f32x4*)(a0 + c); b1 = *(const f32x4*)(a0 + c + 4); }
#pragma unroll
            for (int ai = 0; ai < 2; ++ai)
#pragma unroll
                for (int m = 0; m < 4; ++m) { const size_t off = (size_t)(row0 + ai * 128 + m * 16) * 512 + c;
                    f32x4 v0 = acc[ai][bj][m][0] + b0, v1 = acc[ai][bj][m][1] + b1;
                    if (KIND == 0) {
#pragma unroll
                        for (int j = 0; j < 4; ++j) {
                            v0[j] = __expf(-0.60653066f * sigmoidf_(v0[j])); v1[j] = __expf(-0.60653066f * sigmoidf_(v1[j])); }
                        *(f32x4*)(decay + off) = v0; *(f32x4*)(decay + off + 4) = v1;
                    } else {
                        if (KIND == 1) {
#pragma unroll
                            for (int j = 0; j < 4; ++j) { v0[j] = sigmoidf_(v0[j]); v1[j] = sigmoidf_(v1[j]); } }
                        u32x4 w; w.x = pg8::cvt_pk_bf16(v0[0], v0[1]); w.y = pg8::cvt_pk_bf16(v0[2], v0[3]); w.z = pg8::cvt_pk_bf16(v1[0], v1[1]); w.w = pg8::cvt_pk_bf16(v1[2], v1[3]);
                        *(u32x4*)((KIND == 1 ? ab : gb) + off) = w; }
                    asm volatile("" ::: "memory");
                }
        }
    }
};
struct EpiGate {
    static constexpr bool PERM = true, AFTER_DRAIN = false;
    bf16_t* Y; float* part;
    __device__ __forceinline__ void operator()(const f32x4 (&acc)[2][2][4][2], const Unit& u, int wr, int wc, int fr, int fq) const {
        const int row0 = u.pm * 256 + wr * 64 + fr, b = u.pn >> 2, pc = u.pn & 3;
        const bf16_t* Yb = Y + (size_t)b * NT * DM;
#pragma unroll
        for (int ai = 0; ai < 2; ++ai)
#pragma unroll
            for (int m = 0; m < 4; ++m)
#pragma unroll
                for (int bj = 0; bj < 2; ++bj) { const size_t off = (size_t)(row0 + ai * 128 + m * 16) * DM + pc * 256 + bj * 128 + wc * 32 + 8 * fq;
                    const u32x4 y = *(const u32x4*)(Yb + off); float o[8];
                    const float yv[8] = {bf_lo(y.x), bf_hi(y.x), bf_lo(y.y), bf_hi(y.y), bf_lo(y.z), bf_hi(y.z), bf_lo(y.w), bf_hi(y.w)};
#pragma unroll
                    for (int n = 0; n < 2; ++n)
#pragma unroll
                        for (int j = 0; j < 4; ++j) o[n * 4 + j] = sigmoidf_(acc[ai][bj][m][n][j]) * yv[n * 4 + j];
                    if (b > 0) { const u32x4 q = *(const u32x4*)(Y + off);
                        o[0] += bf_lo(q.x); o[1] += bf_hi(q.x); o[2] += bf_lo(q.y); o[3] += bf_hi(q.y); o[4] += bf_lo(q.z); o[5] += bf_hi(q.z); o[6] += bf_lo(q.w); o[7] += bf_hi(q.w); }
                    u32x4 w; w.x = pg8::cvt_pk_bf16(o[0], o[1]); w.y = pg8::cvt_pk_bf16(o[2], o[3]); w.z = pg8::cvt_pk_bf16(o[4], o[5]); w.w = pg8::cvt_pk_bf16(o[6], o[7]);
                    *(u32x4*)(Y + off) = w;
                }
    }
};
struct EpiStoreQ {
    static constexpr bool PERM = true, AFTER_DRAIN = false;
    bf16_t* Qh; float* qs4;
    __device__ __forceinline__ void operator()(const f32x4 (&acc)[2][2][4][2], const Unit& u, int wr, int wc, int fr, int fq) const {
        const int row0 = u.pm * 256 + wr * 64 + fr; bf16_t* base = Qh + (size_t)u.pn * NT * 256;
#pragma unroll
        for (int ai = 0; ai < 2; ++ai)
#pragma unroll
            for (int m = 0; m < 4; ++m) { const int row = row0 + ai * 128 + m * 16; float sq = 0.f;
#pragma unroll
                for (int bj = 0; bj < 2; ++bj) { const f32x4 v0 = acc[ai][bj][m][0], v1 = acc[ai][bj][m][1]; u32x4 w;
                    w.x = pg8::cvt_pk_bf16(v0[0], v0[1]); w.y = pg8::cvt_pk_bf16(v0[2], v0[3]); w.z = pg8::cvt_pk_bf16(v1[0], v1[1]); w.w = pg8::cvt_pk_bf16(v1[2], v1[3]);
                    *(u32x4*)(base + (size_t)row * 256 + bj * 128 + wc * 32 + 8 * fq) = w;
                    sq += (v0[0] * v0[0] + v0[1] * v0[1]) + (v0[2] * v0[2] + v0[3] * v0[3]) + (v1[0] * v1[0] + v1[1] * v1[1]) + (v1[2] * v1[2] + v1[3] * v1[3]); }
                sq += __shfl_xor(sq, 16); sq += __shfl_xor(sq, 32);
                if (fq == 0) qs4[((size_t)u.pn * NT + row) * 4 + wc] = sq; }
    }
};
struct EpiScore {
    static constexpr bool PERM = true, AFTER_DRAIN = false;
    bf16_t* P; const float* qs4; float* rs4;
    __device__ __forceinline__ void operator()(const f32x4 (&acc)[2][2][4][2], const Unit& u, int wr, int wc, int fr, int fq) const {
        const int row0 = u.pm * 256 + wr * 64 + fr;
#pragma unroll
        for (int ai = 0; ai < 2; ++ai)
#pragma unroll
            for (int m = 0; m < 4; ++m) { const int R = row0 + ai * 128 + m * 16; const f32x4 s4 = *(const f32x4*)(qs4 + (size_t)R * 4);
                const float sc = rsqrtf(((s4.x + s4.y) + (s4.z + s4.w)) * (1.f / 256.f) + 1e-6f); float sum = 0.f;
#pragma unroll
                for (int bj = 0; bj < 2; ++bj) { float o[8];
#pragma unroll
                    for (int n = 0; n < 2; ++n)
#pragma unroll
                        for (int j = 0; j < 4; ++j) { const float ev = __expf(acc[ai][bj][m][n][j] * sc); o[n * 4 + j] = ev; sum += ev; }
                    u32x4 w; w.x = pg8::cvt_pk_bf16(o[0], o[1]); w.y = pg8::cvt_pk_bf16(o[2], o[3]); w.z = pg8::cvt_pk_bf16(o[4], o[5]); w.w = pg8::cvt_pk_bf16(o[6], o[7]);
                    *(u32x4*)(P + (size_t)R * 256 + bj * 128 + wc * 32 + 8 * fq) = w; }
                sum += __shfl_xor(sum, 16); sum += __shfl_xor(sum, 32);
                if (fq == 0) rs4[(size_t)R * 4 + wc] = sum; }
    }
};
struct EpiPV {
    static constexpr bool PERM = true, AFTER_DRAIN = false;
    bf16_t* O; const float* rs4;
    __device__ __forceinline__ void operator()(const f32x4 (&acc)[2][2][4][2], const Unit& u, int wr, int wc, int fr, int fq) const {
        const int row0 = u.pm * 256 + wr * 64 + fr;
#pragma unroll
        for (int ai = 0; ai < 2; ++ai)
#pragma unroll
            for (int m = 0; m < 4; ++m) { const int R = row0 + ai * 128 + m * 16; const f32x4 s4 = *(const f32x4*)(rs4 + (size_t)R * 4); const float inv = 1.0f / ((s4.x + s4.y) + (s4.z + s4.w)); const int hd = R >> 15, tok = R & 32767;
#pragma unroll
                for (int bj = 0; bj < 2; ++bj) { const f32x4 v0 = acc[ai][bj][m][0] * inv, v1 = acc[ai][bj][m][1] * inv; u32x4 w;
                    w.x = pg8::cvt_pk_bf16(v0[0], v0[1]); w.y = pg8::cvt_pk_bf16(v0[2], v0[3]); w.z = pg8::cvt_pk_bf16(v1[0], v1[1]); w.w = pg8::cvt_pk_bf16(v1[2], v1[3]);
                    *(u32x4*)(O + (size_t)tok * DM + hd * 256 + bj * 128 + wc * 32 + 8 * fq) = w; } }
    }
};
struct DiagOrder {
    int G, c;
    __device__ bool next(int i, Unit& u) const { const int v = (G & 7) ? c : (c & 7) * (G >> 3) + (c >> 3);
        const int L = i * G + v; if (L >= 512) return false; u.pm = L; u.pn = L >> 4; return true; }
    __device__ __forceinline__ void a_ready(const Unit&) const {}
    __device__ __forceinline__ void done(const Unit&) const {}
};
struct GateOrder {
    int G, c;
    __device__ bool next(int i, Unit& u) const { const int v = (G & 7) ? c : (c & 7) * (G >> 3) + (c >> 3);
        const int T = (i / 3) * G + v; if (T >= 512) return false; const int b = i % 3; u.pm = T >> 2; u.pn = b * 4 + (T & 3); return true; }
    __device__ __forceinline__ void a_ready(const Unit&) const {}
    __device__ __forceinline__ void done(const Unit&) const {}
};

template <class Epi> __device__ __forceinline__ void run_gemm(LAS unsigned char* lds, const bf16_t* A, const bf16_t* Bt, int M, int N, int K, const Epi& E) {
    pg8::Gemm g{A, Bt, M, N, K}; pg8::StaticOrder S; S.init(M, N, (int)gridDim.x, (int)blockIdx.x);
    pg8::gemm_phase<Epi, pg8::StaticOrder, true, true>(lds, g, S, E);
}

__device__ __forceinline__ void tr_item(const float* W, int ldw, int c0, int K, bf16_t* WT, int r0, LAS float* scr, int kb, int lane) {
    const int k0 = 64 * kb;
#pragma unroll
    for (int i = 0; i < 8; ++i) { const int kk = 8 * i + (lane >> 3); const f32x4 v = *(const f32x4*)(W + (size_t)(k0 + kk) * ldw + c0 + 4 * (lane & 7));
        LAS float* d = scr + kk * 33 + 4 * (lane & 7); d[0] = v.x; d[1] = v.y; d[2] = v.z; d[3] = v.w; }
    LDS_WAIT();
    const int c = lane >> 3;
#pragma unroll
    for (int j = 0; j < 4; ++j) { const int n = (lane & 7) + 8 * j; const LAS float* s = scr + (8 * c) * 33 + n;
        u32x4 o; o.x = pk2(s[0 * 33], s[1 * 33]); o.y = pk2(s[2 * 33], s[3 * 33]); o.z = pk2(s[4 * 33], s[5 * 33]); o.w = pk2(s[6 * 33], s[7 * 33]);
        *(u32x4*)(WT + (size_t)(r0 + n) * K + k0 + 8 * c) = o; }
    LDS_WAIT();
}
__device__ __forceinline__ void conv_job(LAS unsigned char* lds, const float* W, int ldw, int c0, int ncols, int K, bf16_t* WT, int mode, int rot) {
    const int tid = otid(), lane = tid & 63, wave = tid >> 6, NGW = gridDim.x * 8; int gw = blockIdx.x * 8 + wave + rot; while (gw >= NGW) gw -= NGW;
    LAS float* scr = (LAS float*)(lds + wave * 8448);
    const int nblk = ncols / 32, nitems = (K / 64) * nblk;
    for (int it = gw; it < nitems; it += NGW) { const int kb = it / nblk, nb = it % nblk;
        const int sc = mode ? (((nb >> 2) & 1) * DFF + 128 * (nb >> 3) + 32 * (nb & 3)) : (c0 + 32 * nb);
        tr_item(W, ldw, sc, K, WT, 32 * nb, scr, kb, lane); }
}
__device__ __forceinline__ void norm_rows(const float* src, const float* gain, bf16_t* dst, int nrows) {
    const int tid = otid(), lane = tid & 63, gw = blockIdx.x * 8 + (tid >> 6), NGW = gridDim.x * 8;
    f32x4 g[4];
#pragma unroll
    for (int j = 0; j < 4; ++j) g[j] = *((const f32x4*)gain + lane + 64 * j);
#pragma unroll 4
    for (int m = gw; m < nrows; m += NGW) {
        const f32x4* xr = (const f32x4*)(src + (size_t)m * DM) + lane; f32x4 v[4]; float s = 0.f;
#pragma unroll
        for (int j = 0; j < 4; ++j) { v[j] = xr[64 * j]; s += (v[j].x * v[j].x + v[j].y * v[j].y) + (v[j].z * v[j].z + v[j].w * v[j].w); }
        const float r = rsqrtf(wave_sum_fast(s) * (1.f / DM) + 1e-6f);
        u32x2* o8 = (u32x2*)(dst + (size_t)m * DM) + lane;
#pragma unroll
        for (int j = 0; j < 4; ++j) { u32x2 w; w.x = pk2(v[j].x * r * g[j].x, v[j].y * r * g[j].y); w.y = pk2(v[j].z * r * g[j].z, v[j].w * r * g[j].w); o8[64 * j] = w; }
    }
}

__device__ __forceinline__ void rw_prep(const bf16_t* prw, const float* mu, bf16_t* xr, bf16_t* xk, bf16_t* xv, bf16_t* ap) {
    const int tid = otid(), lane = tid & 63, gw = blockIdx.x * 8 + (tid >> 6), NGW = gridDim.x * 8;
#pragma unroll 2
    for (int m = gw; m < NT; m += NGW) {
        const int t = m & (SEQ - 1); const bf16_t* p = prw + (size_t)m * 1824;
#pragma unroll
        for (int k = 0; k < 4; ++k) { const int g = lane + 64 * k;
            if (g < 228) { const int c = 8 * g;
                float cur[8], prv[8]; ld8(p + c, cur);
                if (t) ld8(p - 1824 + c, prv); else {
#pragma unroll
                    for (int i = 0; i < 8; ++i) prv[i] = 0.f; }
                const f32x4 m0 = *(const f32x4*)(mu + c), m1 = *(const f32x4*)(mu + c + 4); const float mv[8] = {m0.x, m0.y, m0.z, m0.w, m1.x, m1.y, m1.z, m1.w};
                float x[8];
#pragma unroll
                for (int i = 0; i < 8; ++i) x[i] = cur[i] + (prv[i] - cur[i]) * mv[i];
                bf16_t* dst;
                if (c < 1536) dst = (c < 512 ? xr : (c < 1024 ? xk : xv)) + (size_t)m * 512 + (c & 511);
                else if (c < 1600) {
#pragma unroll
                    for (int i = 0; i < 8; ++i) x[i] = tanhf(x[i]);
                    dst = ap + (size_t)m * 384 + (c - 1536); }
                else if (c < 1664) dst = ap + (size_t)m * 384 + 64 + (c - 1600);
                else {
#pragma unroll
                    for (int i = 0; i < 8; ++i) x[i] = sigmoidf_(x[i]);
                    dst = ap + (size_t)m * 384 + 128 + (c - 1664); }
                u32x4 w; w.x = pk2(x[0], x[1]); w.y = pk2(x[2], x[3]); w.z = pk2(x[4], x[5]); w.w = pk2(x[6], x[7]);
                *(u32x4*)dst = w; } }
        if (lane < 12) *(u32x4*)(ap + (size_t)m * 384 + 288 + 8 * lane) = (u32x4){0u, 0u, 0u, 0u};
    }
}
struct RwP { const bf16_t *xr, *xk, *xv, *ab, *gb; const float* decay; const float *k_k, *k_a, *r_k, *ln_w, *ln_b; bf16_t* ya; };
struct RwOps { f32x4 r, w, k, a, b; float v; };
struct RwIn { u32x2 r, kx, v, a; f32x4 w; };
__device__ __forceinline__ float hex_sum(float v) { v += dpp_f<0xB1>(v); v += dpp_f<0x4E>(v); v += dpp_f<0x141>(v); v += dpp_f<0x140>(v); return v; }
__device__ __forceinline__ void rw_ld(RwOps& o, const LAS float* OPb, int t, int cg, int row) {
    const LAS float* base = OPb + t * 64 + 4 * cg;
    o.r = *(const LAS f32x4*)(base); o.w = *(const LAS f32x4*)(base + 1024); o.k = *(const LAS f32x4*)(base + 2048); o.a = *(const LAS f32x4*)(base + 4096); o.b = *(const LAS f32x4*)(base + 5120);
    o.v = OPb[3 * 1024 + t * 64 + row];
}
__device__ __forceinline__ float rw_step(f32x2v (&S)[2], const RwOps& o) {
    f32x2v s0 = S[0] * (f32x2v){o.a.x, o.a.y}; s0 += S[1] * (f32x2v){o.a.z, o.a.w};
    const float sa = hex_sum(s0.x + s0.y);
    const f32x2v t0 = (f32x2v){o.b.x, o.b.y} * sa + (f32x2v){o.k.x, o.k.y} * o.v, t1 = (f32x2v){o.b.z, o.b.w} * sa + (f32x2v){o.k.z, o.k.w} * o.v;
    S[0] = S[0] * (f32x2v){o.w.x, o.w.y} + t0; S[1] = S[1] * (f32x2v){o.w.z, o.w.w} + t1;
    f32x2v y0 = S[0] * (f32x2v){o.r.x, o.r.y}; y0 += S[1] * (f32x2v){o.r.z, o.r.w};
    return y0.x + y0.y;
}
__device__ __forceinline__ void rw_load_in(RwIn& G, const RwP& P, size_t idx) {
    G.r = *(const u32x2*)(P.xr + idx); G.kx = *(const u32x2*)(P.xk + idx); G.v = *(const u32x2*)(P.xv + idx); G.a = *(const u32x2*)(P.ab + idx); G.w = *(const f32x4*)(P.decay + idx);
}
__device__ __forceinline__ void rw_prep_chunk(const RwIn& G, LAS float* dst  , f32x4 kkc, f32x4 kac) {
    const f32x4 r = {bf_lo(G.r.x), bf_hi(G.r.x), bf_lo(G.r.y), bf_hi(G.r.y)}, kx = {bf_lo(G.kx.x), bf_hi(G.kx.x), bf_lo(G.kx.y), bf_hi(G.kx.y)};
    const f32x4 v = {bf_lo(G.v.x), bf_hi(G.v.x), bf_lo(G.v.y), bf_hi(G.v.y)}, a = {bf_lo(G.a.x), bf_hi(G.a.x), bf_lo(G.a.y), bf_hi(G.a.y)};
    f32x4 kk = kx * kkc; const float nrm = sqrtf(hex_sum((kk.x * kk.x + kk.y * kk.y) + (kk.z * kk.z + kk.w * kk.w))); kk = kk * __builtin_amdgcn_rcpf(fmaxf(nrm, 1e-12f));
    const f32x4 k2 = kx * ((a - 1.0f) * kac + 1.0f);
    *(LAS f32x4*)(dst) = r; *(LAS f32x4*)(dst + 1024) = G.w; *(LAS f32x4*)(dst + 2048) = k2; *(LAS f32x4*)(dst + 3072) = v; *(LAS f32x4*)(dst + 4096) = -kk; *(LAS f32x4*)(dst + 5120) = kk * a;
}
__device__ __forceinline__ float rw_ysum(const LAS float* yp) { const LAS f32x4* q = (const LAS f32x4*)yp; const f32x4 a = q[0], b = q[1], c = q[2], d = q[3];
    return ((a.x + a.y) + (a.z + a.w)) + ((b.x + b.y) + (b.z + b.w)) + ((c.x + c.y) + (c.z + c.w)) + ((d.x + d.y) + (d.z + d.w)); }
#define RW_BAR() do { asm volatile("s_waitcnt lgkmcnt(0)" ::: "memory"); __builtin_amdgcn_s_barrier(); asm volatile("" ::: "memory"); } while (0)
__device__ __forceinline__ void rw_scan(LAS unsigned char* lds, const RwP& P, int unit, bf16_t* yraw) {
    const int tid = otid(), rq = unit & 3, bh = unit >> 2, b = bh >> 3, h = bh & 7, lane = tid & 63, wave = __builtin_amdgcn_readfirstlane(tid >> 6), hw = wave - 4, col = h * 64 + lane;
    LAS float* OP = (LAS float*)lds; LAS float* Y = OP + 2 * 6144;
    constexpr int NC = SEQ / 16;
    if (wave < 4) {
        const int cg = lane & 15, rl = 4 * wave + (lane >> 4), row = 16 * rq + rl;
        f32x2v S[2]; S[0] = (f32x2v){0.f, 0.f}; S[1] = (f32x2v){0.f, 0.f};
        RW_BAR();
        for (int c = 0; c < NC; ++c) {
            const LAS float* OPb = OP + (c & 1) * 6144; LAS float* Yb = Y + (c & 1) * 4096 + rl * 16 + cg;
            RwOps A, B;
            rw_ld(A, OPb, 0, cg, row);
#pragma unroll
            for (int t = 0; t < 16; t += 2) {
                rw_ld(B, OPb, t + 1, cg, row);
                Yb[t * 256] = rw_step(S, A);
                if (t + 2 < 16) rw_ld(A, OPb, t + 2, cg, row);
                Yb[(t + 1) * 256] = rw_step(S, B);
            }
            RW_BAR();
        }
        RW_BAR();
    } else {
        const int ht = tid - 256, yt = ht >> 4, yr = ht & 15, cq = lane & 15, pt = 4 * hw + (lane >> 4);
        const f32x4 kkc = *(const f32x4*)(P.k_k + h * 64 + 4 * cq), kac = *(const f32x4*)(P.k_a + h * 64 + 4 * cq);
        bf16_t* ydst = yraw + (size_t)(b * SEQ + yt) * 512 + h * 64 + 16 * rq + yr;
        const size_t ibase = (size_t)(b * SEQ + pt) * 512 + h * 64 + 4 * cq; const int poff = pt * 64 + 4 * cq;
        RwIn G0, G1, G2;
        rw_load_in(G0, P, ibase);
        rw_prep_chunk(G0, OP + poff, kkc, kac);
        rw_load_in(G1, P, ibase + (size_t)1 * 16 * 512);
        rw_load_in(G2, P, ibase + (size_t)2 * 16 * 512);
        RW_BAR();
#define RW_ITER(c_, GLD, GUSE) if ((c_) < NC) { const int cc_ = (c_), bf = cc_ & 1; \
            if (cc_ + 3 < NC) rw_load_in(GLD, P, ibase + (size_t)(cc_ + 3) * 16 * 512); \
            if (cc_ > 0) ydst[(size_t)(cc_ - 1) * 16 * 512] = (bf16_t)f2bf(rw_ysum(Y + (bf ^ 1) * 4096 + ht * 16)); \
            if (cc_ + 1 < NC) rw_prep_chunk(GUSE, OP + (bf ^ 1) * 6144 + poff, kkc, kac); \
            RW_BAR(); }
        for (int c = 0; c < NC; c += 3) { RW_ITER(c, G0, G1) RW_ITER(c + 1, G1, G2) RW_ITER(c + 2, G2, G0) }
#undef RW_ITER
        RW_BAR();
        ydst[(size_t)(NC - 1) * 16 * 512] = (bf16_t)f2bf(rw_ysum(Y + ((NC - 1) & 1) * 4096 + ht * 16));
    }
    __syncthreads();
}
#undef RW_BAR
__device__ __forceinline__ float oct_sum(float v) { v += dpp_f<0xB1>(v); v += dpp_f<0x4E>(v); v += dpp_f<0x141>(v); return v; }
__device__ __forceinline__ void rw_post_pass(const RwP& P, const bf16_t* yraw) {
    const int tid = otid(), lane = tid & 63, gw = blockIdx.x * 8 + (tid >> 6), NGW = gridDim.x * 8, c0 = 8 * lane;
    float ka[8], rk[8], lw[8], lb[8];
#pragma unroll
    for (int j = 0; j < 8; ++j) { ka[j] = P.k_a[c0 + j]; rk[j] = P.r_k[c0 + j]; lw[j] = P.ln_w[c0 + j]; lb[j] = P.ln_b[c0 + j]; }
#pragma unroll 2
    for (int m = gw; m < NT; m += NGW) { const size_t idx = (size_t)m * 512 + c0;
        float y[8], r[8], kx[8], v[8], a[8], g[8]; ld8(yraw + idx, y); ld8(P.xr + idx, r); ld8(P.xk + idx, kx); ld8(P.xv + idx, v); ld8(P.ab + idx, a); ld8(P.gb + idx, g);
        float sb = 0.f, sy = 0.f;
#pragma unroll
        for (int j = 0; j < 8; ++j) { const float k2 = kx[j] * (1.0f + (a[j] - 1.0f) * ka[j]); sb += r[j] * k2 * rk[j]; sy += y[j]; }
        const float bonus = oct_sum(sb), mean = oct_sum(sy) * (1.f / 64.f); float sv = 0.f;
#pragma unroll
        for (int j = 0; j < 8; ++j) { y[j] -= mean; sv += y[j] * y[j]; }
        const float rstd = rsqrtf(oct_sum(sv) * (1.f / 64.f) + 64e-5f); float o[8];
#pragma unroll
        for (int j = 0; j < 8; ++j) o[j] = (y[j] * rstd * lw[j] + lb[j] + bonus * v[j]) * g[j];
        u32x4 w; w.x = pk2(o[0], o[1]); w.y = pk2(o[2], o[3]); w.z = pk2(o[4], o[5]); w.w = pk2(o[6], o[7]);
        *(u32x4*)(P.ya + idx) = w; }
}

typedef short bf16x8_t __attribute__((ext_vector_type(8)));
typedef float f32x16 __attribute__((ext_vector_type(16)));
__device__ __forceinline__ bf16x8_t pack8(float a0, float a1, float a2, float a3, float a4, float a5, float a6, float a7) {
    u32x4 pz;
    asm volatile("s_nop 0\n\tv_cvt_pk_bf16_f32 %0, %4, %5\n\tv_cvt_pk_bf16_f32 %1, %6, %7\n\tv_cvt_pk_bf16_f32 %2, %8, %9\n\tv_cvt_pk_bf16_f32 %3, %10, %11\n\ts_nop 1"
                 : "=&v"(pz.x), "=&v"(pz.y), "=&v"(pz.z), "=&v"(pz.w) : "v"(a0), "v"(a1), "v"(a2), "v"(a3), "v"(a4), "v"(a5), "v"(a6), "v"(a7));
    return __builtin_bit_cast(bf16x8_t, pz); }
struct DilRaw { u32x4 k[4], v[4], q[2]; };
__device__ __forceinline__ void dil_load(const bf16_t* pdr, int unit, DilRaw& R) {
    const int tid = otid();
    const int rn = unit & 31, h = (unit >> 5) & 7, g = (unit >> 8) % 3, bl = unit / 768;
    const int ld = 2 * g, d = 1 << ld, rr = rn & (d - 1), n = rn >> ld;
    const int qcol = g * 1536 + h * 64, rowbase = bl * SEQ;
    const int row = tid >> 1, hf = tid & 1, mp = 128 * (n - 1) + row;
    if (mp >= 0) { const bf16_t* src = pdr + (size_t)(rowbase + mp * d + rr) * 6144 + qcol + hf * 32;
#pragma unroll
        for (int i = 0; i < 4; ++i) { R.k[i] = *(const u32x4*)(src + 512 + 8 * i); R.v[i] = *(const u32x4*)(src + 1024 + 8 * i); } }
    else {
#pragma unroll
        for (int i = 0; i < 4; ++i) { R.k[i] = (u32x4){0u, 0u, 0u, 0u}; R.v[i] = (u32x4){0u, 0u, 0u, 0u}; } }
    const int q = tid >> 2, p = tid & 3; const bf16_t* qs = pdr + (size_t)(rowbase + (128 * n + q) * d + rr) * 6144 + qcol + 16 * p;
    R.q[0] = *(const u32x4*)qs; R.q[1] = *(const u32x4*)(qs + 8);
}
__device__ __forceinline__ void up8(const u32x4 u, float* f) { f[0] = bf_lo(u.x); f[1] = bf_hi(u.x); f[2] = bf_lo(u.y); f[3] = bf_hi(u.y); f[4] = bf_lo(u.z); f[5] = bf_hi(u.z); f[6] = bf_lo(u.w); f[7] = bf_hi(u.w); }
__device__ __forceinline__ void dil_unit(LAS unsigned char* lds, const bf16_t* pdr, int unit, const DilRaw& R, int next_unit, DilRaw& Rn, const float* gq, const float* gk, const float* dcos, const float* dsin, bf16_t* og, float* deng) {
    const int tid = otid();
    const int rn = unit & 31, h = (unit >> 5) & 7, g = (unit >> 8) % 3, bl = unit / 768;
    const int ld = 2 * g, d = 1 << ld, rr = rn & (d - 1), n = rn >> ld;
    LAS bf16_t* Qs = (LAS bf16_t*)lds; LAS bf16_t* Ks = Qs + 128 * 72; LAS bf16_t* Vt = Ks + 256 * 72; LAS float* Xc = (LAS float*)(Vt + 64 * 260);
    const int qcol = g * 1536 + h * 64, rowbase = bl * SEQ;
    {   const int row = tid >> 1, hf = tid & 1, mp = 128 * (n - 1) + row;
        float kf[32];
        if (mp >= 0) { const int tk = mp * d + rr;
#pragma unroll
            for (int i = 0; i < 4; ++i) up8(R.k[i], kf + 8 * i);
            float ss = 0.f;
#pragma unroll
            for (int i = 0; i < 32; ++i) ss += kf[i] * kf[i];
            ss += __shfl_xor(ss, 1);
            const float rs = rsqrtf(ss * (1.f / 64.f) + 1e-6f);
#pragma unroll
            for (int i = 0; i < 32; ++i) kf[i] = kf[i] * rs * gk[g * 64 + hf * 32 + i];
            if (hf == 0) {
#pragma unroll
                for (int i = 0; i < 8; ++i) { const float c = dcos[tk * 8 + i], s = dsin[tk * 8 + i], x1 = kf[i], x2 = kf[i + 8]; kf[i] = x1 * c - x2 * s; kf[i + 8] = x2 * c + x1 * s; } }
        } else {
#pragma unroll
            for (int i = 0; i < 32; ++i) kf[i] = 0.f;
        }
#pragma unroll
        for (int i = 0; i < 4; ++i) { u32x4 w; w.x = pk2(kf[8 * i], kf[8 * i + 1]); w.y = pk2(kf[8 * i + 2], kf[8 * i + 3]); w.z = pk2(kf[8 * i + 4], kf[8 * i + 5]); w.w = pk2(kf[8 * i + 6], kf[8 * i + 7]);
            *(LAS u32x4*)(Ks + row * 72 + hf * 32 + 8 * i) = w; }
#pragma unroll
        for (int i = 0; i < 4; ++i) { const unsigned vv[4] = {R.v[i].x, R.v[i].y, R.v[i].z, R.v[i].w};
#pragma unroll
            for (int x = 0; x < 4; ++x) { Vt[(hf * 32 + 8 * i + 2 * x) * 260 + row] = (bf16_t)(vv[x] & 0xffffu); Vt[(hf * 32 + 8 * i + 2 * x + 1) * 260 + row] = (bf16_t)(vv[x] >> 16); } }
    }
    {   const int q = tid >> 2, p = tid & 3, tq = (128 * n + q) * d + rr;
        float qf[16]; up8(R.q[0], qf); up8(R.q[1], qf + 8);
        float ss = 0.f;
#pragma unroll
        for (int i = 0; i < 16; ++i) ss += qf[i] * qf[i];
        ss += __shfl_xor(ss, 1); ss += __shfl_xor(ss, 2);
        const float rs = rsqrtf(ss * (1.f / 64.f) + 1e-6f) * 0.125f;
#pragma unroll
        for (int i = 0; i < 16; ++i) qf[i] = qf[i] * rs * gq[g * 64 + 16 * p + i];
        if (p == 0) {
#pragma unroll
            for (int i = 0; i < 8; ++i) { const float c = dcos[tq * 8 + i], s = dsin[tq * 8 + i], x1 = qf[i], x2 = qf[i + 8]; qf[i] = x1 * c - x2 * s; qf[i + 8] = x2 * c + x1 * s; } }
#pragma unroll
        for (int i = 0; i < 2; ++i) { u32x4 w; w.x = pk2(qf[8 * i], qf[8 * i + 1]); w.y = pk2(qf[8 * i + 2], qf[8 * i + 3]); w.z = pk2(qf[8 * i + 4], qf[8 * i + 5]); w.w = pk2(qf[8 * i + 6], qf[8 * i + 7]);
            *(LAS u32x4*)(Qs + q * 72 + 16 * p + 8 * i) = w; }
    }
    __syncthreads();
    dil_load(pdr, next_unit, Rn);
    const int wv = __builtin_amdgcn_readfirstlane(tid >> 6), qt = wv & 3, kh = wv >> 2, lane = tid & 63, r = lane & 31, hh = lane >> 5;
    bf16x8_t qb[4];
#pragma unroll
    for (int ks = 0; ks < 4; ++ks) qb[ks] = *(const LAS bf16x8_t*)(Qs + (32 * qt + r) * 72 + 16 * ks + 8 * hh);
    f32x16 y0, y1; float den = 0.f;
#pragma unroll
    for (int i = 0; i < 16; ++i) { y0[i] = 0.f; y1[i] = 0.f; }
    const int qi = 32 * qt + r;
    for (int k4 = 0; k4 < 4; ++k4) { const int kt = 4 * kh + k4;
        if (kt < qt || kt > qt + 4) continue;
        f32x16 x;
#pragma unroll
        for (int i = 0; i < 16; ++i) x[i] = 0.f;
#pragma unroll
        for (int ks = 0; ks < 4; ++ks) { const bf16x8_t ka = *(const LAS bf16x8_t*)(Ks + (32 * kt + r) * 72 + 16 * ks + 8 * hh); x = __builtin_amdgcn_mfma_f32_32x32x16_bf16(ka, qb[ks], x, 0, 0, 0); }
#pragma unroll
        for (int i = 0; i < 16; ++i) { const int ki = 32 * kt + (i & 3) + 8 * (i >> 2) + 4 * hh;
            const bool valid = (ki >= qi) && (ki <= qi + 128) && (n > 0 || ki >= 128);
            const float e = valid ? __expf(x[i]) : 0.f; den += e; x[i] = e; }
#pragma unroll
        for (int s = 0; s < 2; ++s) { const bf16x8_t xs = pack8(x[8 * s], x[8 * s + 1], x[8 * s + 2], x[8 * s + 3], x[8 * s + 4], x[8 * s + 5], x[8 * s + 6], x[8 * s + 7]);
            const int kcol = 32 * kt + 16 * s + 4 * hh;
            {   const u32x2 lo = *(const LAS u32x2*)(Vt + r * 260 + kcol), hi = *(const LAS u32x2*)(Vt + r * 260 + kcol + 8); u32x4 v4; v4.x = lo.x; v4.y = lo.y; v4.z = hi.x; v4.w = hi.y;
                y0 = __builtin_amdgcn_mfma_f32_32x32x16_bf16(__builtin_bit_cast(bf16x8_t, v4), xs, y0, 0, 0, 0); }
            {   const u32x2 lo = *(const LAS u32x2*)(Vt + (32 + r) * 260 + kcol), hi = *(const LAS u32x2*)(Vt + (32 + r) * 260 + kcol + 8); u32x4 v4; v4.x = lo.x; v4.y = lo.y; v4.z = hi.x; v4.w = hi.y;
                y1 = __builtin_amdgcn_mfma_f32_32x32x16_bf16(__builtin_bit_cast(bf16x8_t, v4), xs, y1, 0, 0, 0); }
        }
    }
    den += __shfl_xor(den, 32);
    LAS float* xc = Xc + (qt * 64 + lane) * 33;
    if (kh == 1) {
#pragma unroll
        for (int i = 0; i < 16; ++i) { xc[i] = y0[i]; xc[16 + i] = y1[i]; }
        xc[32] = den; }
    __syncthreads();
    if (kh == 0) {
#pragma unroll
        for (int i = 0; i < 16; ++i) { y0[i] += xc[i]; y1[i] += xc[16 + i]; }
        den += xc[32];
        const float inv = 1.0f / den; const int tq = (128 * n + qi) * d + rr; const size_t orow = (size_t)g * CH + rowbase + tq;
        bf16_t* dst = og + orow * 512 + h * 64 + 4 * hh;
#pragma unroll
        for (int gI = 0; gI < 4; ++gI) { u32x2 w0, w1; w0.x = pk2(y0[4 * gI] * inv, y0[4 * gI + 1] * inv); w0.y = pk2(y0[4 * gI + 2] * inv, y0[4 * gI + 3] * inv);
            w1.x = pk2(y1[4 * gI] * inv, y1[4 * gI + 1] * inv); w1.y = pk2(y1[4 * gI + 2] * inv, y1[4 * gI + 3] * inv);
            *(u32x2*)(dst + 8 * gI) = w0; *(u32x2*)(dst + 32 + 8 * gI) = w1; }
        if (hh == 0) deng[orow * 8 + h] = den;
    }
    __syncthreads();
}
__device__ __forceinline__ void dil_combine(const bf16_t* og, const float* deng, bf16_t* yb  ) {
    const int NI = CH * 64;
#pragma unroll 2
    for (int it = blockIdx.x * 512 + otid(); it < NI; it += gridDim.x * 512) { const int tok = it >> 6, c8 = (it & 63) * 8, h = c8 >> 6;
        const float d0 = deng[(size_t)tok * 8 + h], d1 = deng[((size_t)CH + tok) * 8 + h], d2 = deng[((size_t)2 * CH + tok) * 8 + h]; const float inv = 1.0f / (d0 + d1 + d2);
        float a[8], b[8], c[8]; ld8(og + (size_t)tok * 512 + c8, a); ld8(og + ((size_t)CH + tok) * 512 + c8, b); ld8(og + ((size_t)2 * CH + tok) * 512 + c8, c);
        float o[8];
#pragma unroll
        for (int i = 0; i < 8; ++i) o[i] = (d0 * a[i] + d1 * b[i] + d2 * c[i]) * inv;
        u32x4 w; w.x = pk2(o[0], o[1]); w.y = pk2(o[2], o[3]); w.z = pk2(o[4], o[5]); w.w = pk2(o[6], o[7]);
        *(u32x4*)(yb + (size_t)tok * 512 + c8) = w; }
}

__device__ __forceinline__ void ret_load_k(const bf16_t* src  , int t, int qq, const float* rcos, const float* rsin, float scale, float* o1, float* o2) {
    float x1[8], x2[8]; ld8(src + 8 * qq, x1); ld8(src + 32 + 8 * qq, x2);
#pragma unroll
    for (int e = 0; e < 8; ++e) { const float c = rcos[t * 32 + 8 * qq + e], s = rsin[t * 32 + 8 * qq + e]; o1[e] = (x1[e] * c - x2[e] * s) * scale; o2[e] = (x2[e] * c + x1[e] * s) * scale; }
}
__device__ __forceinline__ void retA_unit(LAS unsigned char* lds, const bf16_t* pdr, int unit, const float* rcos, const float* rsin, float* kvst) {
    const int tid = otid(), c = unit & 31, h = (unit >> 5) & 3, bl = unit >> 7;
    const float lg = logf(1.0f - exp2f(-5.0f - (float)h));
    LAS float* Ks = (LAS float*)lds; LAS float* Vs = Ks + 128 * 64;
    {   const int row = tid >> 2, qq = tid & 3, t = c * 128 + row; const bf16_t* src = pdr + (size_t)(bl * SEQ + t) * 6144 + 4608;
        float o1[8], o2[8]; ret_load_k(src + 256 + h * 64, t, qq, rcos, rsin, 0.125f * __expf(lg * (float)(127 - row)), o1, o2);
#pragma unroll
        for (int e = 0; e < 8; ++e) { Ks[row * 64 + 8 * qq + e] = o1[e]; Ks[row * 64 + 32 + 8 * qq + e] = o2[e]; }
#pragma unroll
        for (int i = 0; i < 4; ++i) { float v[8]; ld8(src + 512 + h * 128 + 32 * qq + 8 * i, v);
            *(LAS f32x4*)(Vs + row * 128 + 32 * qq + 8 * i) = (f32x4){v[0], v[1], v[2], v[3]}; *(LAS f32x4*)(Vs + row * 128 + 32 * qq + 8 * i + 4) = (f32x4){v[4], v[5], v[6], v[7]}; }
    }
    __syncthreads();
    const int dd = tid >> 3, e0 = (tid & 7) * 16;
    f32x4 a0 = {0.f, 0.f, 0.f, 0.f}, a1 = a0, a2 = a0, a3 = a0;
    for (int j = 0; j < 128; ++j) { const float kd = Ks[j * 64 + dd]; const LAS f32x4* vr = (const LAS f32x4*)(Vs + j * 128 + e0);
        a0 += vr[0] * kd; a1 += vr[1] * kd; a2 += vr[2] * kd; a3 += vr[3] * kd; }
    float* dst = kvst + (size_t)unit * 8192 + dd * 128 + e0;
    *(f32x4*)dst = a0; *(f32x4*)(dst + 4) = a1; *(f32x4*)(dst + 8) = a2; *(f32x4*)(dst + 12) = a3;
    __syncthreads();
}
__device__ __forceinline__ void retC_unit(LAS unsigned char* lds, const bf16_t* pdr, int unit, const float* rcos, const float* rsin, const float* kvst, const float* gain, bf16_t* yc  ) {
    const int tid = otid(), lane = tid & 63, c = unit & 31, h = (unit >> 5) & 3, bl = unit >> 7;
    const float lg = logf(1.0f - exp2f(-5.0f - (float)h)), gC = __expf(lg * 128.0f);
    LAS bf16_t* Qs = (LAS bf16_t*)lds; LAS bf16_t* Ks = Qs + 128 * 72; LAS bf16_t* Vt = Ks + 128 * 72; LAS bf16_t* St = Vt + 128 * 132; LAS float* Xc = (LAS float*)(St + 128 * 72);
    {
        f32x4 s0 = {0.f, 0.f, 0.f, 0.f}, s1 = s0, s2 = s0, s3 = s0;
        const float* kp = kvst + (size_t)(unit - c) * 8192 + tid * 16;
        int cc = 0;
        for (; cc + 4 <= c; cc += 4) { f32x4 kq[4][4];
#pragma unroll
            for (int q = 0; q < 4; ++q) { const f32x4* k4 = (const f32x4*)(kp + (size_t)(cc + q) * 8192); kq[q][0] = k4[0]; kq[q][1] = k4[1]; kq[q][2] = k4[2]; kq[q][3] = k4[3]; }
#pragma unroll
            for (int q = 0; q < 4; ++q) { s0 = s0 * gC + kq[q][0]; s1 = s1 * gC + kq[q][1]; s2 = s2 * gC + kq[q][2]; s3 = s3 * gC + kq[q][3]; } }
        for (; cc < c; ++cc) { const f32x4* k4 = (const f32x4*)(kp + (size_t)cc * 8192); s0 = s0 * gC + k4[0]; s1 = s1 * gC + k4[1]; s2 = s2 * gC + k4[2]; s3 = s3 * gC + k4[3]; }
        const int dd = tid >> 3, e0 = (tid & 7) * 16; const float sv[16] = {s0.x, s0.y, s0.z, s0.w, s1.x, s1.y, s1.z, s1.w, s2.x, s2.y, s2.z, s2.w, s3.x, s3.y, s3.z, s3.w};
#pragma unroll
        for (int x = 0; x < 16; ++x) St[(e0 + x) * 72 + dd] = (bf16_t)f2bf(sv[x]);
        const int row = tid >> 2, qq = tid & 3, t = c * 128 + row; const bf16_t* src = pdr + (size_t)(bl * SEQ + t) * 6144 + 4608;
        float o1[8], o2[8];
        ret_load_k(src + 256 + h * 64, t, qq, rcos, rsin, 0.125f, o1, o2);
        *(LAS u32x4*)(Ks + row * 72 + 8 * qq) = (u32x4){pk2(o1[0], o1[1]), pk2(o1[2], o1[3]), pk2(o1[4], o1[5]), pk2(o1[6], o1[7])};
        *(LAS u32x4*)(Ks + row * 72 + 32 + 8 * qq) = (u32x4){pk2(o2[0], o2[1]), pk2(o2[2], o2[3]), pk2(o2[4], o2[5]), pk2(o2[6], o2[7])};
        ret_load_k(src + h * 64, t, qq, rcos, rsin, 1.0f, o1, o2);
        *(LAS u32x4*)(Qs + row * 72 + 8 * qq) = (u32x4){pk2(o1[0], o1[1]), pk2(o1[2], o1[3]), pk2(o1[4], o1[5]), pk2(o1[6], o1[7])};
        *(LAS u32x4*)(Qs + row * 72 + 32 + 8 * qq) = (u32x4){pk2(o2[0], o2[1]), pk2(o2[2], o2[3]), pk2(o2[4], o2[5]), pk2(o2[6], o2[7])};
#pragma unroll
        for (int i = 0; i < 4; ++i) { const u32x4 v = *(const u32x4*)(src + 512 + h * 128 + 32 * qq + 8 * i); const unsigned vv[4] = {v.x, v.y, v.z, v.w};
#pragma unroll
            for (int x = 0; x < 4; ++x) { Vt[(32 * qq + 8 * i + 2 * x) * 132 + row] = (bf16_t)(vv[x] & 0xffffu); Vt[(32 * qq + 8 * i + 2 * x + 1) * 132 + row] = (bf16_t)(vv[x] >> 16); } }
    }
    __syncthreads();
    const int wv = __builtin_amdgcn_readfirstlane(tid >> 6), qt = wv & 3, eh = wv >> 2, r = lane & 31, hh = lane >> 5, qi = 32 * qt + r;
    bf16x8_t qb[4], qc[4];
    {   const float qd = __expf(lg * (float)(qi + 1));
#pragma unroll
        for (int ks = 0; ks < 4; ++ks) { const u32x4 u = *(const LAS u32x4*)(Qs + qi * 72 + 16 * ks + 8 * hh); qb[ks] = __builtin_bit_cast(bf16x8_t, u);
            qc[ks] = pack8(bf_lo(u.x) * qd, bf_hi(u.x) * qd, bf_lo(u.y) * qd, bf_hi(u.y) * qd, bf_lo(u.z) * qd, bf_hi(u.z) * qd, bf_lo(u.w) * qd, bf_hi(u.w) * qd); }
    }
    f32x16 y0, y1;
#pragma unroll
    for (int i = 0; i < 16; ++i) { y0[i] = 0.f; y1[i] = 0.f; }
    const int er0 = (64 * eh + r) * 132, er1 = (64 * eh + 32 + r) * 132;
    for (int kt = 0; kt <= qt; ++kt) {
        f32x16 x;
#pragma unroll
        for (int i = 0; i < 16; ++i) x[i] = 0.f;
#pragma unroll
        for (int ks = 0; ks < 4; ++ks) { const bf16x8_t ka = *(const LAS bf16x8_t*)(Ks + (32 * kt + r) * 72 + 16 * ks + 8 * hh); x = __builtin_amdgcn_mfma_f32_32x32x16_bf16(ka, qb[ks], x, 0, 0, 0); }
#pragma unroll
        for (int i = 0; i < 16; ++i) { const int j = 32 * kt + (i & 3) + 8 * (i >> 2) + 4 * hh; x[i] = (j <= qi) ? x[i] * __expf(lg * (float)(qi - j)) : 0.f; }
#pragma unroll
        for (int s = 0; s < 2; ++s) { const bf16x8_t xs = pack8(x[8 * s], x[8 * s + 1], x[8 * s + 2], x[8 * s + 3], x[8 * s + 4], x[8 * s + 5], x[8 * s + 6], x[8 * s + 7]);
            const int kcol = 32 * kt + 16 * s + 4 * hh;
            {   const u32x2 lo = *(const LAS u32x2*)(Vt + er0 + kcol), hi = *(const LAS u32x2*)(Vt + er0 + kcol + 8); u32x4 v4; v4.x = lo.x; v4.y = lo.y; v4.z = hi.x; v4.w = hi.y;
                y0 = __builtin_amdgcn_mfma_f32_32x32x16_bf16(__builtin_bit_cast(bf16x8_t, v4), xs, y0, 0, 0, 0); }
            {   const u32x2 lo = *(const LAS u32x2*)(Vt + er1 + kcol), hi = *(const LAS u32x2*)(Vt + er1 + kcol + 8); u32x4 v4; v4.x = lo.x; v4.y = lo.y; v4.z = hi.x; v4.w = hi.y;
                y1 = __builtin_amdgcn_mfma_f32_32x32x16_bf16(__builtin_bit_cast(bf16x8_t, v4), xs, y1, 0, 0, 0); }
        }
    }
#pragma unroll
    for (int ks = 0; ks < 4; ++ks) {
        const bf16x8_t sa0 = *(const LAS bf16x8_t*)(St + (64 * eh + r) * 72 + 16 * ks + 8 * hh), sa1 = *(const LAS bf16x8_t*)(St + (64 * eh + 32 + r) * 72 + 16 * ks + 8 * hh);
        y0 = __builtin_amdgcn_mfma_f32_32x32x16_bf16(sa0, qc[ks], y0, 0, 0, 0); y1 = __builtin_amdgcn_mfma_f32_32x32x16_bf16(sa1, qc[ks], y1, 0, 0, 0); }
    float ss = 0.f;
#pragma unroll
    for (int i = 0; i < 16; ++i) ss += y0[i] * y0[i] + y1[i] * y1[i];
    ss += __shfl_xor(ss, 32);
    if (hh == 0) Xc[eh * 128 + qi] = ss;
    __syncthreads();
    const float rms = rsqrtf((Xc[qi] + Xc[128 + qi]) * (1.f / 128.f) + 1e-6f);
    const int t = c * 128 + qi; const bf16_t* gsrc = pdr + (size_t)(bl * SEQ + t) * 6144 + 4608 + 1024 + h * 128 + 64 * eh + 4 * hh;
    bf16_t* dst = yc + (size_t)(bl * SEQ + t) * 512 + h * 128 + 64 * eh + 4 * hh; const float* gn = gain + h * 128 + 64 * eh + 4 * hh;
#pragma unroll
    for (int gI = 0; gI < 4; ++gI) {
        {   const u32x2 gb = *(const u32x2*)(gsrc + 8 * gI); const f32x4 g4 = *(const f32x4*)(gn + 8 * gI); const float gv[4] = {bf_lo(gb.x), bf_hi(gb.x), bf_lo(gb.y), bf_hi(gb.y)}; float o[4];
#pragma unroll
            for (int x = 0; x < 4; ++x) o[x] = gv[x] * sigmoidf_(gv[x]) * (y0[4 * gI + x] * rms * g4[x]);
            u32x2 w; w.x = pk2(o[0], o[1]); w.y = pk2(o[2], o[3]); *(u32x2*)(dst + 8 * gI) = w; }
        {   const u32x2 gb = *(const u32x2*)(gsrc + 32 + 8 * gI); const f32x4 g4 = *(const f32x4*)(gn + 32 + 8 * gI); const float gv[4] = {bf_lo(gb.x), bf_hi(gb.x), bf_lo(gb.y), bf_hi(gb.y)}; float o[4];
#pragma unroll
            for (int x = 0; x < 4; ++x) o[x] = gv[x] * sigmoidf_(gv[x]) * (y1[4 * gI + x] * rms * g4[x]);
            u32x2 w; w.x = pk2(o[0], o[1]); w.y = pk2(o[2], o[3]); *(u32x2*)(dst + 32 + 8 * gI) = w; }
    }
    __syncthreads();
}

enum { I_X = 0, I_MEM, I_NORM_FFN1, I_FFN1_W13, I_FFN1_W2, I_NORM_MIX, I_W_IN, I_RW_MU, I_RW_W0, I_RW_W2, I_RW_A0, I_RW_A2, I_RW_G2, I_RW_KK, I_RW_KA, I_RW_RK, I_RW_LNW, I_RW_LNB,
       I_DIL_QN, I_DIL_KN, I_RET_NORM, I_WB_RWKV, I_WB_DIL, I_WB_RET, I_W_OUT, I_NORM_XA, I_NORM_MEM, I_XA_WQ, I_XA_WKV, I_XA_QN, I_XA_KN, I_XA_WO, I_NORM_FFN2, I_FFN2_W13, I_FFN2_W2, N_IN };
struct Args { const float* in[N_IN]; float* out; unsigned char* ws; };
typedef const float* fptr_t;
__device__ __forceinline__ fptr_t ld_in(int i) { const __attribute__((address_space(4))) fptr_t* p = (const __attribute__((address_space(4))) fptr_t*)__builtin_amdgcn_kernarg_segment_ptr(); asm volatile("" : "+s"(p)); return p[i]; }

#define XB_TMO      128
#define XB_XCNT(j)  (256  + 64 * (j))
#define XB_XSUB(j)  (1280 + 64 * (j))
#define XB_XGEN(j)  (2304 + 64 * (j))
#define XB_TOP      3328
#define XB_TOPGEN   3392
#define XCD_BAR_WORDS 3456
#define XB_SPIN_CAP (1u << 18)

__device__ __forceinline__ unsigned xb_ld(unsigned* p)              { return __hip_atomic_load(p, __ATOMIC_RELAXED, __HIP_MEMORY_SCOPE_AGENT); }
__device__ __forceinline__ unsigned xb_add(unsigned* p, unsigned v) { return __hip_atomic_fetch_add(p, v, __ATOMIC_RELAXED, __HIP_MEMORY_SCOPE_AGENT); }
__device__ __forceinline__ unsigned xb_xcc_id() { return (unsigned)__builtin_amdgcn_s_getreg((3 << 11) | 20) & 0xFu; }
#define XB_SPIN(cond, bar) do { unsigned _sp = 0; while (cond) { __builtin_amdgcn_s_sleep(1); \
    if ((++_sp & 255u) == 0u) { if (xb_ld(&(bar)[XB_TMO])) break; if (_sp > XB_SPIN_CAP) { atomicAdd(&(bar)[XB_TMO], 1u); break; } } } } while (0)

struct XcdBarrier {
    unsigned* bar; unsigned x;
    volatile LAS unsigned* st;
};

__device__ __forceinline__ XcdBarrier xcd_barrier_post(unsigned* bar, volatile LAS unsigned* st) {
    XcdBarrier b; b.bar = bar; b.x = xb_xcc_id(); b.st = st;
    if (threadIdx.x == 0) (void)xb_add(&bar[XB_XCNT(b.x)], 1u);
    return b;
}
__device__ __forceinline__ void xcd_barrier_complete(unsigned* bar, unsigned x, unsigned& nloc, unsigned& nx) {
    const unsigned G = gridDim.x * gridDim.y * gridDim.z;
    unsigned sum, cnt, mine, sp = 0u;
    for (;;) {
        sum = 0u; cnt = 0u; mine = 0u;
#pragma unroll
        for (unsigned j = 0; j < 16; ++j) { const unsigned c = xb_ld(&bar[XB_XCNT(j)]); sum += c; cnt += (c > 0u) ? 1u : 0u; mine = (j == x) ? c : mine; }
        if (sum == G) break;
        __builtin_amdgcn_s_sleep(1);
        if ((++sp & 255u) == 0u) { if (xb_ld(&bar[XB_TMO])) break; if (sp > XB_SPIN_CAP) { atomicAdd(&bar[XB_TMO], 1u); break; } }
    }
    nloc = mine > 0u ? mine : 1u; nx = cnt > 0u ? cnt : 1u;
}

__device__ __forceinline__ void xcd_barrier(const XcdBarrier& b) {
    asm volatile("s_waitcnt vmcnt(0)" ::: "memory");
    __syncthreads();
    if (threadIdx.x == 0) {
        unsigned* bar = b.bar;
        __builtin_amdgcn_s_waitcnt(0);
        unsigned nloc = b.st[0], nx = b.st[1];
        if (nloc == 0u) { xcd_barrier_complete(bar, b.x, nloc, nx); b.st[0] = nloc; b.st[1] = nx; }
        const unsigned old = xb_add(&bar[XB_XSUB(b.x)], 1u);
        const unsigned gen = old / nloc;
        if (old + 1u == (gen + 1u) * nloc) {
            __builtin_amdgcn_fence(__ATOMIC_RELEASE, "agent");
            asm volatile("s_waitcnt vmcnt(0)" ::: "memory");
            const unsigned og = xb_add(&bar[XB_TOP], 1u);
            const unsigned tg = og / nx;
            if (og + 1u == (tg + 1u) * nx) xb_add(&bar[XB_TOPGEN], 1u);
            else XB_SPIN(xb_ld(&bar[XB_TOPGEN]) == tg, bar);
            __builtin_amdgcn_fence(__ATOMIC_ACQUIRE, "agent");
            xb_add(&bar[XB_XGEN(b.x)], 1u);
            asm volatile("s_waitcnt vmcnt(0)" ::: "memory");
        } else {
            XB_SPIN(xb_ld(&bar[XB_XGEN(b.x)]) == gen, bar);
            __builtin_amdgcn_fence(__ATOMIC_ACQUIRE, "agent");
            asm volatile("s_waitcnt vmcnt(0)" ::: "memory");
        }
    }
    __syncthreads();
}

constexpr int XB_LDS_OFF = LDS_BYTES - 16;
__device__ __forceinline__ unsigned char* wsp(size_t off) { const __attribute__((address_space(4))) fptr_t* p = (const __attribute__((address_space(4))) fptr_t*)__builtin_amdgcn_kernarg_segment_ptr(); asm volatile("" : "+s"(p)); return (unsigned char*)p[N_IN + 1] + off; }
__device__ __forceinline__ float* ld_out() { const __attribute__((address_space(4))) fptr_t* p = (const __attribute__((address_space(4))) fptr_t*)__builtin_amdgcn_kernarg_segment_ptr(); asm volatile("" : "+s"(p)); return (float*)p[N_IN]; }
#define TP(mib) (wsp(WS_T + (size_t)(mib) * MiB))
#define WB ((bf16_t*)wsp(WS_WB))
#define KVB ((bf16_t*)wsp(WS_KV))
#define U ((bf16_t*)wsp(WS_U))
#define hbuf (ld_out())
#define dcos ((float*)wsp(WS_TAB))
#define dsin ((float*)wsp(WS_TAB) + SEQ * 8)
#define rcos ((float*)wsp(WS_TAB) + SEQ * 16)
#define rsin ((float*)wsp(WS_TAB) + SEQ * 48)
#define prw ((bf16_t*)TP(0))
#define xr ((bf16_t*)TP(114))
#define xk ((bf16_t*)TP(146))
#define xv ((bf16_t*)TP(178))
#define ap ((bf16_t*)TP(210))
#define decay ((float*)TP(0))
#define abuf ((bf16_t*)TP(64))
#define gbuf ((bf16_t*)TP(234))
#define ya ((bf16_t*)TP(266))
#define yb ((bf16_t*)TP(298))
#define yc ((bf16_t*)TP(330))
#define pdr ((bf16_t*)TP(0))
#define og ((bf16_t*)TP(192))
#define deng ((float*)TP(240))
#define kvst ((float*)TP(242))
#define Yb ((bf16_t*)TP(0))
#define part ((float*)TP(192))
#define Qh ((bf16_t*)TP(0))
#define rq ((float*)TP(64))
#define rs ((float*)TP(66))
#define Pm ((bf16_t*)TP(68))
#define Ob ((bf16_t*)TP(132))
#define FFA ((bf16_t*)TP(0))
__global__ void __launch_bounds__(512, 2) fwd_kernel(Args a) {
    extern __shared__ __attribute__((aligned(16))) unsigned char lds_raw[];
    LAS unsigned char* lds = (LAS unsigned char*)lds_raw;
    cg::grid_group grid = cg::this_grid();
    if (otid() < 4) ((LAS unsigned*)(lds + XB_LDS_OFF))[otid()] = 0u;
    __syncthreads();
    if (blockIdx.x == 0) for (int i = otid(); i < 4096; i += 512) ((unsigned*)wsp(0))[i] = 0u;
#define GSYNC() do { XcdBarrier b_; b_.bar = (unsigned*)wsp(0); b_.x = xb_xcc_id(); b_.st = (volatile LAS unsigned*)(lds + XB_LDS_OFF); xcd_barrier(b_); } while (0)
    const int G = gridDim.x, bx = blockIdx.x, GT = G * 512;
    const int vx = (G & 7) ? bx : (bx & 7) * (G >> 3) + (bx >> 3);
#define gtid (bx * 512 + otid())
#define lane (otid() & 63)
#define wave (otid() >> 6)

    for (int i = gtid; i < SEQ * 40; i += GT) {
        if (i < SEQ * 8) { const int t = i >> 3, k = i & 7; const float inv = powf(500000.0f, -(float)k / 8.0f); const float ang = (float)t * inv; dcos[i] = cosf(ang); dsin[i] = sinf(ang); }
        else { const int i2 = i - SEQ * 8, t = i2 >> 5, k = i2 & 31; const float inv = powf(10000.0f, -(float)k / 32.0f); const float ang = (float)t * inv; rcos[i2] = cosf(ang); rsin[i2] = sinf(ang); }
    }
    {   bf16_t* wkvt = (bf16_t*)TP(0);
        bf16_t* mn = (bf16_t*)TP(8);
        for (int l = 0; l < 2; ++l) {
            conv_job(lds, ld_in(I_XA_WKV) + (size_t)l * 1024 * 2048, 2048, 0, 2048, 1024, wkvt + (size_t)l * 2048 * 1024, 0, 0);
            norm_rows(ld_in(I_MEM), ld_in(I_NORM_MEM) + l * DM, mn + (size_t)l * 2048 * 1024, 2048);
        }
    }
    grid.sync();
    {   XcdBarrier b0 = xcd_barrier_post((unsigned*)wsp(0), (volatile LAS unsigned*)(lds + XB_LDS_OFF)); (void)b0; }
    {   bf16_t* wkvt = (bf16_t*)TP(0); bf16_t* mn = (bf16_t*)TP(8); float* kvraw = (float*)TP(330);
        for (int l = 0; l < 2; ++l) { EpiF32 E{kvraw + (size_t)l * 2048 * 2048, 2048}; run_gemm(lds, mn + (size_t)l * 2048 * 1024, wkvt + (size_t)l * 2048 * 1024, 2048, 2048, 1024, E); }
    }

    for (int l = 0; l < 2; ++l) {
        const float* hin = l == 0 ? ld_in(I_X) : hbuf;
        {   const float* w13a = ld_in(I_FFN1_W13) + (size_t)l * 1024 * 5632; const float* w2a = ld_in(I_FFN1_W2) + (size_t)l * 2816 * 1024;
            const float* w13b = ld_in(I_FFN2_W13) + (size_t)l * 1024 * 5632; const float* w2b = ld_in(I_FFN2_W2) + (size_t)l * 2816 * 1024;
            const float* win = ld_in(I_W_IN) + (size_t)l * 1024 * 11040;
            conv_job(lds, w13a, 5632, 0, 5632, 1024, WB + WO_W13A, 1, 0);
            conv_job(lds, w2a, 1024, 0, 1024, 2816, WB + WO_W2A, 0, 768);
            conv_job(lds, w13b, 5632, 0, 5632, 1024, WB + WO_W13B, 1, 128);
            conv_job(lds, w2b, 1024, 0, 1024, 2816, WB + WO_W2B, 0, 896);
            conv_job(lds, win, 11040, 0, 1824, 1024, WB + WO_RW, 0, 256);
            conv_job(lds, win, 11040, 1824, 6144, 1024, WB + WO_DR, 0, 1168);
            conv_job(lds, win, 11040, 7968, 3072, 1024, WB + WO_G, 0, 144);
            conv_job(lds, ld_in(I_WB_RWKV) + (size_t)l * 512 * 1024, 1024, 0, 1024, 512, WB + WO_BR, 0, 1680);
            conv_job(lds, ld_in(I_WB_DIL) + (size_t)l * 512 * 1024, 1024, 0, 1024, 512, WB + WO_BR + 1024 * 512, 0, 1936);
            conv_job(lds, ld_in(I_WB_RET) + (size_t)l * 512 * 1024, 1024, 0, 1024, 512, WB + WO_BR + 2 * 1024 * 512, 0, 144);
            conv_job(lds, ld_in(I_W_OUT) + (size_t)l * 1024 * 1024, 1024, 0, 1024, 1024, WB + WO_OUT, 0, 400);
            conv_job(lds, ld_in(I_XA_WQ) + (size_t)l * 1024 * 1024, 1024, 0, 1024, 1024, WB + WO_Q, 0, 912);
            conv_job(lds, ld_in(I_XA_WO) + (size_t)l * 1024 * 1024, 1024, 0, 1024, 1024, WB + WO_O, 0, 1424);
            { unsigned zz = 0u; asm volatile("" : "+v"(zz)); for (int i = gtid; i < 224 * 1024 / 8; i += GT) *((u32x4*)(WB + WO_RW + 1824 * 1024) + i) = (u32x4){zz, zz, zz, zz}; }
            const float* w2l = ld_in(I_RW_W2) + (size_t)l * 64 * 512; const float* a2l = ld_in(I_RW_A2) + (size_t)l * 64 * 512; const float* g2l = ld_in(I_RW_G2) + (size_t)l * 160 * 512;
            for (int i = gtid; i < 1536 * 384; i += GT) { const int n = i / 384, k = i - n * 384; float v = 0.f;
                if (n < 512) { if (k < 64) v = w2l[k * 512 + n]; }
                else if (n < 1024) { if (k >= 64 && k < 128) v = a2l[(k - 64) * 512 + n - 512]; }
                else { if (k >= 128 && k < 288) v = g2l[(k - 128) * 512 + n - 1024]; }
                WB[WO_LORA + i] = (bf16_t)f2bf(v); }
            norm_rows(hin, ld_in(I_NORM_FFN1) + l * DM, U, NT);
        }
        GSYNC();
        if (l == 0)
        {   const float* kvraw = (const float*)TP(330);
            for (int l = 0; l < 2; ++l) { const float* raw = kvraw + (size_t)l * 2048 * 2048; bf16_t* Kp = KVB + (size_t)l * 4 * 1024 * 1024; bf16_t* Vt = Kp + 2 * 1024 * 1024;
                const float* gq = ld_in(I_XA_QN) + l * 256; const float* gk = ld_in(I_XA_KN) + l * 256;
                for (int it = bx * 8 + wave; it < 2048 * 4; it += G * 8) { const int row = it >> 2, hd = it & 3, b = row >> 8, m = row & 255;
                    const f32x4 k4 = *(const f32x4*)(raw + (size_t)row * 2048 + hd * 256 + 4 * lane);
                    const float ss = wave_sum((k4.x * k4.x + k4.y * k4.y) + (k4.z * k4.z + k4.w * k4.w)); const float rk = rsqrtf(ss * (1.f / 256.f) + 1e-6f) * 0.0625f;
                    const f32x4 g1 = *(const f32x4*)(gq + 4 * lane), g2 = *(const f32x4*)(gk + 4 * lane);
                    u32x2 w; w.x = pk2(k4.x * rk * g1.x * g2.x, k4.y * rk * g1.y * g2.y); w.y = pk2(k4.z * rk * g1.z * g2.z, k4.w * rk * g1.w * g2.w);
                    *(u32x2*)(Kp + ((size_t)(hd * 8 + b) * 256 + m) * 256 + 4 * lane) = w; }
                {   LAS float* tl = (LAS float*)(lds + wave * 16640);
                    for (int tile = bx * 8 + wave; tile < 512; tile += G * 8) { const int hb = tile >> 4, mt = (tile >> 2) & 3, dt = tile & 3, hd = hb >> 3, b = hb & 7;
                        for (int r = 0; r < 64; ++r) tl[r * 65 + lane] = raw[(size_t)(b * 256 + 64 * mt + r) * 2048 + 1024 + hd * 256 + 64 * dt + lane];
                        LDS_WAIT();
                        for (int dd = 0; dd < 64; ++dd) Vt[(size_t)hb * 65536 + (size_t)(64 * dt + dd) * 256 + 64 * mt + lane] = (bf16_t)f2bf(tl[lane * 65 + dd]);
                        LDS_WAIT(); } }
            }
            __syncthreads();
        }
        {   EpiSwiglu E{FFA}; run_gemm(lds, U, WB + WO_W13A, NT, 5632, 1024, E); }
        GSYNC();
        {   EpiResid E{hin, hbuf, 0.5f}; run_gemm(lds, FFA, WB + WO_W2A, NT, 1024, DFF, E); }
        GSYNC();
        norm_rows(hbuf, ld_in(I_NORM_MIX) + l * DM, U, NT);
        GSYNC();
        {   EpiStore E{prw, 1824, 1824, 0, 0}; run_gemm(lds, U, WB + WO_RW, NT, 2048, 1024, E); }
        GSYNC();
        rw_prep(prw, ld_in(I_RW_MU) + l * 1824, xr, xk, xv, ap);
        GSYNC();
        {   EpiLora<0> E0{decay, abuf, gbuf, ld_in(I_RW_W0) + l * 512, ld_in(I_RW_A0) + l * 512}; run_gemm(lds, ap, WB + WO_LORA, NT, 512, 384, E0);
            EpiLora<1> E1{decay, abuf, gbuf, ld_in(I_RW_W0) + l * 512, ld_in(I_RW_A0) + l * 512}; run_gemm(lds, ap, WB + WO_LORA + 512 * 384, NT, 512, 384, E1);
            EpiLora<2> E2{decay, abuf, gbuf, ld_in(I_RW_W0) + l * 512, ld_in(I_RW_A0) + l * 512}; run_gemm(lds, ap, WB + WO_LORA + 1024 * 384, NT, 512, 384, E2); }
        GSYNC();
        {   RwP P{xr, xk, xv, abuf, gbuf, decay, ld_in(I_RW_KK) + l * 512, ld_in(I_RW_KA) + l * 512, ld_in(I_RW_RK) + l * 512, ld_in(I_RW_LNW) + l * 512, ld_in(I_RW_LNB) + l * 512, ya};
            for (int u = bx; u < 256; u += G) { const int x = u & 7, i = u >> 3; rw_scan(lds, P, ((x * 8 + (i >> 2)) << 2) | (i & 3), yb); } }
        GSYNC();
        {   RwP P{xr, xk, xv, abuf, gbuf, decay, ld_in(I_RW_KK) + l * 512, ld_in(I_RW_KA) + l * 512, ld_in(I_RW_RK) + l * 512, ld_in(I_RW_LNW) + l * 512, ld_in(I_RW_LNB) + l * 512, ya};
            rw_post_pass(P, yb); }
        GSYNC();
        {
            for (int ck = 0; ck < 2; ++ck) {
                {   EpiStore E{pdr, 6144, 6144, 0, 0}; run_gemm(lds, U + (size_t)ck * CH * DM, WB + WO_DR, CH, 6144, 1024, E); }
                GSYNC();
                {   DilRaw Ra, Rb; dil_load(pdr, vx < 3072 ? vx : 0, Ra);
                    for (int u = vx; u < 3072 + 512; u += G) {
                        if (u < 3072) { const int nu = u + G; dil_unit(lds, pdr, u, Ra, nu < 3072 ? nu : u, Rb, ld_in(I_DIL_QN) + l * 192, ld_in(I_DIL_KN) + l * 192, dcos, dsin, og, deng); Ra = Rb; }
                        else retA_unit(lds, pdr, u - 3072, rcos, rsin, kvst);
                    } }
                GSYNC();
                for (int u = vx; u < 512; u += G) retC_unit(lds, pdr, u, rcos, rsin, kvst, ld_in(I_RET_NORM) + l * 512, yc + (size_t)ck * CH * 512);
                dil_combine(og, deng, yb + (size_t)ck * CH * 512);
                GSYNC();
            }
        }
        {   for (int b = 0; b < 3; ++b) { EpiStore E{Yb + (size_t)b * NT * DM, DM, DM, 0, 0}; run_gemm(lds, b == 0 ? ya : (b == 1 ? yb : yc), WB + WO_BR + (size_t)b * 1024 * 512, NT, 1024, 512, E); } }
        GSYNC();
        {   EpiGate E{Yb, part}; pg8::Gemm g{U, WB + WO_G, NT, 3072, 1024}; GateOrder S{G, bx}; pg8::gemm_phase<EpiGate, GateOrder, true, true>(lds, g, S, E); }
        GSYNC();
        {   EpiResid E{hbuf, hbuf, 1.0f}; run_gemm(lds, Yb, WB + WO_OUT, NT, 1024, 1024, E); }
        GSYNC();
        norm_rows(hbuf, ld_in(I_NORM_XA) + l * DM, U, NT);
        GSYNC();
        {   EpiStoreQ E{Qh, rq}; run_gemm(lds, U, WB + WO_Q, NT, 1024, 1024, E); }
        GSYNC();
        {   const bf16_t* Kp = KVB + (size_t)l * 4 * 1024 * 1024; EpiScore E{Pm, rq, rs}; pg8::Gemm g{Qh, Kp, 4 * NT, 256, 256}; DiagOrder S{G, bx};
            pg8::gemm_phase<EpiScore, DiagOrder, true, true>(lds, g, S, E); }
        GSYNC();
        {   const bf16_t* Vt = KVB + (size_t)l * 4 * 1024 * 1024 + 2 * 1024 * 1024; EpiPV E{Ob, rs}; pg8::Gemm g{Pm, Vt, 4 * NT, 256, 256}; DiagOrder S{G, bx};
            pg8::gemm_phase<EpiPV, DiagOrder, true, true>(lds, g, S, E); }
        GSYNC();
        {   EpiResid E{hbuf, hbuf, 1.0f}; run_gemm(lds, Ob, WB + WO_O, NT, 1024, 1024, E); }
        GSYNC();
        norm_rows(hbuf, ld_in(I_NORM_FFN2) + l * DM, U, NT);
        GSYNC();
        {   EpiSwiglu E{FFA}; run_gemm(lds, U, WB + WO_W13B, NT, 5632, 1024, E); }
        GSYNC();
        {   EpiResid E{hbuf, hbuf, 0.5f}; run_gemm(lds, FFA, WB + WO_W2B, NT, 1024, DFF, E); }
        if (l == 0) GSYNC();
    }
}

#undef prw
#undef xr
#undef xk
#undef xv
#undef ap
#undef decay
#undef abuf
#undef gbuf
#undef ya
#undef yb
#undef yc
#undef pdr
#undef og
#undef deng
#undef kvst
#undef Yb
#undef part
#undef Qh
#undef rq
#undef rs
#undef Pm
#undef Ob
#undef FFA
#undef gtid
#undef lane
#undef wave
#undef TP
#undef WB
#undef KVB
#undef U
#undef hbuf
#undef dcos
#undef dsin
#undef rcos
#undef rsin
extern "C" void kernel_launch(void* const* d_in, const int* in_sizes, int n_in, void* d_out, int out_size, void* d_ws, size_t ws_size, hipStream_t stream) {
    static int grid = 0;
    if (grid == 0) {
        if (n_in != N_IN || ws_size < WS_END) { fprintf(stderr, "kernel_launch: unexpected n_in %d / ws_size %zu (need %zu)\n", n_in, ws_size, (size_t)WS_END); grid = -1; return; }
        int dev = 0, cus = 0, per_cu = 0;
        (void)hipGetDevice(&dev);
        (void)hipDeviceGetAttribute(&cus, hipDeviceAttributeMultiprocessorCount, dev);
        (void)hipFuncSetAttribute((const void*)fwd_kernel, hipFuncAttributeMaxDynamicSharedMemorySize, LDS_BYTES);
        (void)hipOccupancyMaxActiveBlocksPerMultiprocessor(&per_cu, (const void*)fwd_kernel, 512, LDS_BYTES);
        if (per_cu < 1) per_cu = 1;
        grid = cus * per_cu;
    }
    if (grid < 0) return;
    Args a{};
    for (int i = 0; i < N_IN; ++i) a.in[i] = (const float*)d_in[i];
    a.out = (float*)d_out; a.ws = (unsigned char*)d_ws;
    void* args[] = {&a};
    hipError_t e = hipLaunchCooperativeKernel((void*)fwd_kernel, dim3(grid), dim3(512), args, LDS_BYTES, stream);
    if (e != hipSuccess) fprintf(stderr, "cooperative launch failed: %s (grid %d)\n", hipGetErrorString(e), grid);
}
```

```cpp
#include <hip/hip_runtime.h>
#include <hip/hip_cooperative_groups.h>
#include <cstdio>
#include <cstdint>
namespace cg = cooperative_groups;
namespace pg8 {
#define PG8_LAS __attribute__((address_space(3)))
typedef unsigned short bf16_t;
typedef short bf16x8 __attribute__((ext_vector_type(8)));
typedef float f32x4 __attribute__((ext_vector_type(4)));
typedef unsigned u32x4 __attribute__((ext_vector_type(4)));
constexpr int BM = 256, BK = 64, HALF = 128, HTB = HALF * BK * 2  , STAGE_BYTES = 8 * HTB, NXCD = 8, WGM = 8;

__host__ __device__ __forceinline__ int lds_byte(int r, int c) { const int st = (r >> 4) * 2 + (c >> 5), rr = r & 15, cc = c & 31, ob = rr * 64 + cc * 2; return st * 1024 + (ob ^ (((ob >> 9) & 1) << 5)); }
__host__ __device__ __forceinline__ void stage_rc(int b, int& R, int& C) { const int st = b / 1024, sb = b % 1024, swz = sb ^ (((sb >> 9) & 1) << 5); R = (st >> 1) * 16 + swz / 64; C = (st & 1) * 32 + (swz % 64) / 2; }
__host__ __device__ __forceinline__ int perm32(int rho) { const int n = rho >> 4, i = rho & 15; return 8 * (i >> 2) + 4 * n + (i & 3); }

struct Unit { int pm, pn; };
struct Gemm { const bf16_t* A; const bf16_t* Bt; int M, N, K; };

struct StaticOrder {
    int nM, nN, nwg, G, c;
    __host__ __device__ void init(int M, int N, int G_, int c_) { nM = M / BM; nN = N / BM; nwg = nM * nN; G = G_; c = c_; }
    __host__ __device__ bool next(int i, Unit& u) const {
        const long L = (long)i * G + c; if (L >= nwg) return false;
        int wgid = (int)L; { const int q = nwg / NXCD, r = nwg % NXCD, xcd = wgid % NXCD, off = wgid / NXCD; wgid = (xcd < r ? xcd * (q + 1) : r * (q + 1) + (xcd - r) * q) + off; }
        const int nig = WGM * nN, gid = wgid / nig, fm = gid * WGM, gsz = (nM - fm) < WGM ? (nM - fm) : WGM;
        u.pm = fm + ((wgid % nig) % gsz); u.pn = (wgid % nig) / gsz; return true;
    }
    __device__ __forceinline__ void a_ready(const Unit&) const {}
    __device__ __forceinline__ void done(const Unit&) const {}
};

__device__ __forceinline__ unsigned cvt_pk_bf16(float lo, float hi) { unsigned r; asm volatile("s_nop 0\n\tv_cvt_pk_bf16_f32 %0, %1, %2" : "=v"(r) : "v"(lo), "v"(hi)); return r; }
typedef float f32x2 __attribute__((ext_vector_type(2)));
template <class Epi, class Sched, bool ALIGN_EPI = false, bool SP2 = false>
__device__ __forceinline__ void gemm_phase(PG8_LAS unsigned char* lds, const Gemm g, const Sched& S, const Epi& E) {
    int tid_ = threadIdx.x; asm volatile("" : "+v"(tid_));
    const int tid = tid_, wid = __builtin_amdgcn_readfirstlane(tid >> 6), lane = tid & 63, wr = wid >> 2, wc = wid & 3, fr = lane & 15, fq = lane >> 4;
    const int K = g.K, nt = K / BK;
    unsigned voffA[2], voffB[2];
#pragma unroll
    for (int i = 0; i < 2; ++i) { int R, C; stage_rc(tid * 16 + i * 8192, R, C); const int Rb = Epi::PERM ? ((R & ~31) + perm32(R & 31)) : R;
        voffA[i] = (unsigned)(R * K + C) * 2u; voffB[i] = (unsigned)(Rb * K + C) * 2u; }
    const size_t kstep = (size_t)(BK * 2);
    const size_t hstep = (size_t)HALF * K * 2;
    const size_t tstep = 2 * hstep;
    const unsigned ldsw = (unsigned)wid * 1024u;
    const int aoff = lds_byte(wr * 64 + fr, fq * 8), boff = lds_byte(wc * 32 + fr, fq * 8);
#define PG8_SA(b, h) (((b) * 2 + (h)) * HTB)
#define PG8_SB(b, h) ((4 + (b) * 2 + (h)) * HTB)
#define PG8_STAGE(bufoff, gbase, voff) do { _Pragma("unroll") for (int _i = 0; _i < 2; ++_i) \
        __builtin_amdgcn_global_load_lds((const unsigned*)((const char*)(gbase) + (voff)[_i]), (PG8_LAS unsigned*)(lds + (bufoff) + ldsw + _i * 8192), 16, 0, 0); } while (0)
#define PG8_LDA(dst, b, h) do { _Pragma("unroll") for (int m = 0; m < 4; ++m) _Pragma("unroll") for (int k = 0; k < 2; ++k) dst[m][k] = *(const PG8_LAS bf16x8*)(lds + PG8_SA(b, h) + aoff + m * 2048 + k * 1024); } while (0)
#define PG8_LDB(dst, b, h) do { _Pragma("unroll") for (int n = 0; n < 2; ++n) _Pragma("unroll") for (int k = 0; k < 2; ++k) dst[n][k] = *(const PG8_LAS bf16x8*)(lds + PG8_SB(b, h) + boff + n * 2048 + k * 1024); } while (0)
#define PG8_MMA(ai, bj, At, Bt) do { __builtin_amdgcn_s_setprio(1); _Pragma("unroll") for (int m = 0; m < 4; ++m) _Pragma("unroll") for (int n = 0; n < 2; ++n) _Pragma("unroll") for (int k = 0; k < 2; ++k) \
        acc[ai][bj][m][n] = __builtin_amdgcn_mfma_f32_16x16x32_bf16(Bt[n][k], At[m][k], acc[ai][bj][m][n], 0, 0, 0); __builtin_amdgcn_s_setprio(0); } while (0)
#define PG8_WAIT_V(n) asm volatile("s_waitcnt vmcnt(" #n ")" ::: "memory")
#define PG8_WAIT_L(n) asm volatile("s_waitcnt lgkmcnt(" #n ")" ::: "memory")
#define PG8_BAR __builtin_amdgcn_s_barrier()
#define PG8_SCHED __builtin_amdgcn_sched_barrier(0)
    Unit cur, nxt; int ui = 0;
    if (!S.next(0, cur)) return;
    f32x4 acc[2][2][4][2];
#pragma unroll
    for (int a = 0; a < 2; ++a)
#pragma unroll
        for (int b = 0; b < 2; ++b)
#pragma unroll
            for (int m = 0; m < 4; ++m)
#pragma unroll
                for (int n = 0; n < 2; ++n) acc[a][b][m][n] = (f32x4){0.f, 0.f, 0.f, 0.f};
    bf16x8 At[4][2], B0[2][2], B1[2][2];
    const char* cA = (const char*)g.A + (size_t)cur.pm * tstep; const char* cB = (const char*)g.Bt + (size_t)cur.pn * tstep;
    S.a_ready(cur);
    if constexpr (SP2) {
        PG8_STAGE(PG8_SB(0, 0), cB, voffB); PG8_STAGE(PG8_SB(0, 1), cB + hstep, voffB); PG8_STAGE(PG8_SA(0, 0), cA, voffA); PG8_STAGE(PG8_SA(0, 1), cA + hstep, voffA);
        if (wr == 1) PG8_BAR;
        PG8_WAIT_V(2); PG8_BAR;
        PG8_STAGE(PG8_SB(1, 0), cB + kstep, voffB); PG8_STAGE(PG8_SA(1, 0), cA + kstep, voffA); PG8_STAGE(PG8_SB(1, 1), cB + hstep + kstep, voffB);
        PG8_WAIT_V(6); PG8_BAR;
    } else {
        PG8_STAGE(PG8_SB(0, 0), cB, voffB); PG8_STAGE(PG8_SA(0, 0), cA, voffA); PG8_STAGE(PG8_SB(0, 1), cB + hstep, voffB); PG8_STAGE(PG8_SA(0, 1), cA + hstep, voffA);
        if (wr == 1) PG8_BAR;
        PG8_WAIT_V(4); PG8_BAR;
        PG8_STAGE(PG8_SB(1, 0), cB + kstep, voffB); PG8_STAGE(PG8_SA(1, 0), cA + kstep, voffA); PG8_STAGE(PG8_SB(1, 1), cB + hstep + kstep, voffB);
        PG8_WAIT_V(6); PG8_BAR;
    }
    for (;;) {
        const bool has_next = S.next(ui + 1, nxt);
        const char* nA = has_next ? (const char*)g.A + (size_t)nxt.pm * tstep : cA; const char* nB = has_next ? (const char*)g.Bt + (size_t)nxt.pn * tstep : cB;
#pragma unroll 1
        for (int t = 0; t < nt; t += 2) {
            const bool last = (t == nt - 2);
            const char* a1 = cA + (size_t)(t + 1) * kstep;
            const char* a2 = last ? nA : cA + (size_t)(t + 2) * kstep; const char* b2 = last ? nB : cB + (size_t)(t + 2) * kstep;
            const char* a3 = a2 + kstep; const char* b3 = b2 + kstep;
            if (last && has_next) S.a_ready(nxt);
            if constexpr (SP2) {
            PG8_LDB(B0, 0, 0); PG8_LDB(B1, 0, 1); PG8_SCHED; PG8_LDA(At, 0, 0); PG8_STAGE(PG8_SA(1, 1), a1 + hstep, voffA);
            PG8_WAIT_V(8); PG8_WAIT_L(0); PG8_BAR; PG8_MMA(0, 0, At, B0); PG8_MMA(0, 1, At, B1); PG8_BAR; PG8_SCHED;
            PG8_LDA(At, 0, 1); PG8_STAGE(PG8_SB(0, 0), b2, voffB); PG8_STAGE(PG8_SB(0, 1), b2 + hstep, voffB); PG8_STAGE(PG8_SA(0, 0), a2, voffA);
            PG8_WAIT_V(8); PG8_WAIT_L(0); PG8_BAR; PG8_MMA(1, 0, At, B0); PG8_MMA(1, 1, At, B1); PG8_BAR; PG8_SCHED;
            PG8_LDB(B0, 1, 0); PG8_LDB(B1, 1, 1); PG8_SCHED; PG8_LDA(At, 1, 0); PG8_STAGE(PG8_SA(0, 1), a2 + hstep, voffA);
            PG8_WAIT_V(8); PG8_WAIT_L(0); PG8_BAR; PG8_MMA(0, 0, At, B0); PG8_MMA(0, 1, At, B1); PG8_BAR; PG8_SCHED;
            PG8_LDA(At, 1, 1); PG8_STAGE(PG8_SB(1, 0), b3, voffB); PG8_STAGE(PG8_SB(1, 1), b3 + hstep, voffB); PG8_STAGE(PG8_SA(1, 0), a3, voffA);
            PG8_WAIT_V(8); PG8_WAIT_L(0); PG8_BAR; PG8_MMA(1, 0, At, B0); PG8_MMA(1, 1, At, B1); PG8_BAR; PG8_SCHED;
            } else {
            PG8_LDB(B0, 0, 0); PG8_SCHED; PG8_LDA(At, 0, 0); PG8_STAGE(PG8_SA(1, 1), a1 + hstep, voffA);
            PG8_WAIT_L(8); PG8_BAR; PG8_WAIT_L(0); PG8_MMA(0, 0, At, B0); PG8_BAR; PG8_SCHED;
            PG8_LDB(B1, 0, 1); PG8_STAGE(PG8_SB(0, 0), b2, voffB);
            PG8_BAR; PG8_WAIT_L(0); PG8_MMA(0, 1, At, B1); PG8_BAR;
            PG8_LDA(At, 0, 1); PG8_STAGE(PG8_SA(0, 0), a2, voffA);
            PG8_BAR; PG8_WAIT_L(0); PG8_MMA(1, 0, At, B0); PG8_BAR; PG8_SCHED;
            PG8_STAGE(PG8_SB(0, 1), b2 + hstep, voffB);
            PG8_WAIT_V(6); PG8_BAR; PG8_MMA(1, 1, At, B1); PG8_BAR;
            PG8_LDB(B0, 1, 0); PG8_SCHED; PG8_LDA(At, 1, 0); PG8_STAGE(PG8_SA(0, 1), a2 + hstep, voffA);
            PG8_WAIT_L(8); PG8_BAR; PG8_WAIT_L(0); PG8_MMA(0, 0, At, B0); PG8_BAR; PG8_SCHED;
            PG8_LDB(B1, 1, 1); PG8_STAGE(PG8_SB(1, 0), b3, voffB);
            PG8_BAR; PG8_WAIT_L(0); PG8_MMA(0, 1, At, B1); PG8_BAR;
            PG8_LDA(At, 1, 1); PG8_STAGE(PG8_SA(1, 0), a3, voffA);
            PG8_BAR; PG8_WAIT_L(0); PG8_MMA(1, 0, At, B0); PG8_BAR; PG8_SCHED;
            PG8_STAGE(PG8_SB(1, 1), b3 + hstep, voffB);
            PG8_WAIT_V(6); PG8_BAR; PG8_MMA(1, 1, At, B1); PG8_BAR;
            }
        }
        if constexpr (ALIGN_EPI) { if (wr == 0) PG8_BAR; }
        if constexpr (!Epi::AFTER_DRAIN) { E(acc, cur, wr, wc, fr, fq); S.done(cur); }
        if (!has_next) break;
#pragma unroll
        for (int a = 0; a < 2; ++a)
#pragma unroll
            for (int b = 0; b < 2; ++b)
#pragma unroll
                for (int m = 0; m < 4; ++m)
#pragma unroll
                    for (int n = 0; n < 2; ++n) acc[a][b][m][n] = (f32x4){0.f, 0.f, 0.f, 0.f};
        cur = nxt; cA = nA; cB = nB; ++ui;
        if constexpr (ALIGN_EPI) { if (wr == 1) PG8_BAR; }
    }
    PG8_WAIT_V(0);
    if constexpr (!ALIGN_EPI) { if (wr == 0) PG8_BAR; }
    PG8_BAR;
    if constexpr (Epi::AFTER_DRAIN) { E.fused(acc, cur, wr, wc, fr, fq, lds, wid, lane); S.done(cur); }
#undef PG8_SA
#undef PG8_SB
#undef PG8_STAGE
#undef PG8_LDA
#undef PG8_LDB
#undef PG8_MMA
#undef PG8_WAIT_V
#undef PG8_WAIT_L
#undef PG8_BAR
#undef PG8_SCHED
}
}

#define LAS __attribute__((address_space(3)))
typedef unsigned short bf16_t;
typedef float f32x4 __attribute__((ext_vector_type(4)));
typedef float f32x2v __attribute__((ext_vector_type(2)));
typedef unsigned u32x4 __attribute__((ext_vector_type(4)));
typedef unsigned u32x2 __attribute__((ext_vector_type(2)));

constexpr int NT = 32768, DM = 1024, SEQ = 4096, DFF = 2816;
constexpr int CH = 16384;
constexpr size_t MiB = 1u << 20;
constexpr int LDS_BYTES = 147456;

constexpr size_t WS_TAB = 1 * MiB;
constexpr size_t WS_WB = 4 * MiB;
constexpr size_t WS_KV = 70 * MiB;
constexpr size_t WS_U = 86 * MiB;
constexpr size_t WS_T = 150 * MiB;
constexpr size_t WS_END = 512 * MiB;
constexpr size_t WO_W13A = 0, WO_W2A = WO_W13A + 5632 * 1024, WO_W13B = WO_W2A + 1024 * 2816, WO_W2B = WO_W13B + 5632 * 1024,
                 WO_RW = WO_W2B + 1024 * 2816, WO_DR = WO_RW + 2048 * 1024, WO_G = WO_DR + 6144 * 1024, WO_LORA = WO_G + 3072 * 1024,
                 WO_BR = WO_LORA + 1536 * 384, WO_OUT = WO_BR + 3 * 1024 * 512, WO_Q = WO_OUT + 1024 * 1024, WO_O = WO_Q + 1024 * 1024, WO_ENDW = WO_O + 1024 * 1024;
static_assert(WO_ENDW * 2 <= 66 * MiB, "weights fit");

__device__ __forceinline__ float bf_lo(unsigned u) { return __uint_as_float(u << 16); }
__device__ __forceinline__ float bf_hi(unsigned u) { return __uint_as_float(u & 0xffff0000u); }
__device__ __forceinline__ float bf2f(bf16_t h) { return __uint_as_float((unsigned)h << 16); }
__device__ __forceinline__ unsigned pk2(float lo, float hi) { unsigned r; asm volatile("s_nop 0\n\tv_cvt_pk_bf16_f32 %0, %1, %2" : "=v"(r) : "v"(lo), "v"(hi)); return r; }
__device__ __forceinline__ unsigned f2bf(float f) { return pk2(f, 0.f) & 0xffffu; }
__device__ __forceinline__ float wave_sum(float v) {
#pragma unroll
    for (int o = 1; o < 64; o <<= 1) v += __shfl_xor(v, o);
    return v;
}
template <int CTRL> __device__ __forceinline__ float dpp_f(float v) { return __int_as_float(__builtin_amdgcn_update_dpp(0, __float_as_int(v), CTRL, 0xf, 0xf, true)); }
__device__ __forceinline__ float quad_sum(float v) { v += dpp_f<0xB1>(v); v += dpp_f<0x4E>(v); return v; }
__device__ __forceinline__ float wave_sum_fast(float v) {
    v = quad_sum(v); v += dpp_f<0x141>(v); v += dpp_f<0x140>(v);
    const float a = __int_as_float(__builtin_amdgcn_readlane(__float_as_int(v), 0)), b = __int_as_float(__builtin_amdgcn_readlane(__float_as_int(v), 16)),
                c = __int_as_float(__builtin_amdgcn_readlane(__float_as_int(v), 32)), d = __int_as_float(__builtin_amdgcn_readlane(__float_as_int(v), 48));
    return (a + b) + (c + d);
}
__device__ __forceinline__ float sigmoidf_(float x) { return __builtin_amdgcn_rcpf(1.0f + __expf(-x)); }
__device__ __forceinline__ void ld8(const bf16_t* p, float* f) { const u32x4 u = *(const u32x4*)p;
    f[0] = bf_lo(u.x); f[1] = bf_hi(u.x); f[2] = bf_lo(u.y); f[3] = bf_hi(u.y); f[4] = bf_lo(u.z); f[5] = bf_hi(u.z); f[6] = bf_lo(u.w); f[7] = bf_hi(u.w); }
#define LDS_WAIT() asm volatile("s_waitcnt lgkmcnt(0)" ::: "memory")
__device__ __forceinline__ int otid() { int t = threadIdx.x; asm volatile("" : "+v"(t)); return t; }

using pg8::Unit;
struct EpiStore {
    static constexpr bool PERM = true, AFTER_DRAIN = false;
    bf16_t* O; int ldc; int nvalid; int split_cols; size_t split_stride;
    __device__ __forceinline__ void operator()(const f32x4 (&acc)[2][2][4][2], const Unit& u, int wr, int wc, int fr, int fq) const {
        const int row0 = u.pm * 256 + wr * 64 + fr;
#pragma unroll
        for (int bj = 0; bj < 2; ++bj) {
            int c = u.pn * 256 + bj * 128 + wc * 32 + 8 * fq; if (c >= nvalid) continue;
            bf16_t* base = O; if (split_cols) { const int t = c / split_cols; base += (size_t)t * split_stride; c -= t * split_cols; }
#pragma unroll
            for (int ai = 0; ai < 2; ++ai)
#pragma unroll
                for (int m = 0; m < 4; ++m) { const f32x4 v0 = acc[ai][bj][m][0], v1 = acc[ai][bj][m][1]; u32x4 w;
                    w.x = pg8::cvt_pk_bf16(v0[0], v0[1]); w.y = pg8::cvt_pk_bf16(v0[2], v0[3]); w.z = pg8::cvt_pk_bf16(v1[0], v1[1]); w.w = pg8::cvt_pk_bf16(v1[2], v1[3]);
                    *(u32x4*)(base + (size_t)(row0 + ai * 128 + m * 16) * ldc + c) = w; }
        }
    }
};
struct EpiSwiglu {
    static constexpr bool PERM = true, AFTER_DRAIN = false;
    bf16_t* O;
    __device__ __forceinline__ void operator()(const f32x4 (&acc)[2][2][4][2], const Unit& u, int wr, int wc, int fr, int fq) const {
        const int row0 = u.pm * 256 + wr * 64 + fr, c = u.pn * 128 + wc * 32 + 8 * fq;
#pragma unroll
        for (int ai = 0; ai < 2; ++ai)
#pragma unroll
            for (int m = 0; m < 4; ++m) { float o[8];
#pragma unroll
                for (int n = 0; n < 2; ++n)
#pragma unroll
                    for (int j = 0; j < 4; ++j) { const float a = acc[ai][0][m][n][j], b = acc[ai][1][m][n][j]; o[n * 4 + j] = a * sigmoidf_(a) * b; }
                u32x4 w; w.x = pg8::cvt_pk_bf16(o[0], o[1]); w.y = pg8::cvt_pk_bf16(o[2], o[3]); w.z = pg8::cvt_pk_bf16(o[4], o[5]); w.w = pg8::cvt_pk_bf16(o[6], o[7]);
                *(u32x4*)(O + (size_t)(row0 + ai * 128 + m * 16) * DFF + c) = w; }
    }
};
struct EpiResid {
    static constexpr bool PERM = true, AFTER_DRAIN = false;
    const float* base; float* out; float scale;
    __device__ __forceinline__ void operator()(const f32x4 (&acc)[2][2][4][2], const Unit& u, int wr, int wc, int fr, int fq) const {
        const int row0 = u.pm * 256 + wr * 64 + fr;
#pragma unroll
        for (int ai = 0; ai < 2; ++ai)
#pragma unroll
            for (int m = 0; m < 4; ++m)
#pragma unroll
                for (int bj = 0; bj < 2; ++bj) { const size_t off = (size_t)(row0 + ai * 128 + m * 16) * DM + u.pn * 256 + bj * 128 + wc * 32 + 8 * fq;
                    const f32x4 b0 = *(const f32x4*)(base + off), b1 = *(const f32x4*)(base + off + 4);
                    *(f32x4*)(out + off) = b0 + acc[ai][bj][m][0] * scale; *(f32x4*)(out + off + 4) = b1 + acc[ai][bj][m][1] * scale; }
    }
};
struct EpiF32 {
    static constexpr bool PERM = true, AFTER_DRAIN = false;
    float* out; int ldc;
    __device__ __forceinline__ void operator()(const f32x4 (&acc)[2][2][4][2], const Unit& u, int wr, int wc, int fr, int fq) const {
        const int row0 = u.pm * 256 + wr * 64 + fr;
#pragma unroll
        for (int ai = 0; ai < 2; ++ai)
#pragma unroll
            for (int m = 0; m < 4; ++m)
#pragma unroll
                for (int bj = 0; bj < 2; ++bj) { const size_t off = (size_t)(row0 + ai * 128 + m * 16) * ldc + u.pn * 256 + bj * 128 + wc * 32 + 8 * fq;
                    *(f32x4*)(out + off) = acc[ai][bj][m][0]; *(f32x4*)(out + off + 4) = acc[ai][bj][m][1]; }
    }
};
template <int KIND> struct EpiLora {
    static constexpr bool PERM = true, AFTER_DRAIN = false;
    float* decay; bf16_t* ab; bf16_t* gb; const float* w0; const float* a0;
    __device__ __forceinline__ void operator()(const f32x4 (&acc)[2][2][4][2], const Unit& u, int wr, int wc, int fr, int fq) const {
        const int row0 = u.pm * 256 + wr * 64 + fr;
#pragma unroll
        for (int bj = 0; bj < 2; ++bj) {
            const int c = u.pn * 256 + bj * 128 + wc * 32 + 8 * fq;
            f32x4 b0 = {0.f, 0.f, 0.f, 0.f}, b1 = b0;
            if (KIND == 0) { b0 = *(const f32x4*)(w0 + c); b1 = *(const f32x4*)(w0 + c + 4); }
            if (KIND == 1) { b0 = *(const f32x4*)(a0 + c); b1 = *(const f32x4*)(a0 + c + 4); }
#pragma unroll
            for (int ai = 0; ai < 2; ++ai)
#pragma unroll
                for (int m = 0; m < 4; ++m) { const size_t off = (size_t)(row0 + ai * 128 + m * 16) * 512 + c;
                    f32x4 v0 = acc[ai][bj][m][0] + b0, v1 = acc[ai][bj][m][1] + b1;
                    if (KIND == 0) {
#pragma unroll
                        for (int j = 0; j < 4; ++j) {
                            v0[j] = __expf(-0.60653066f * sigmoidf_(v0[j])); v1[j] = __expf(-0.60653066f * sigmoidf_(v1[j])); }
                        *(f32x4*)(decay + off) = v0; *(f32x4*)(decay + off + 4) = v1;
                    } else {
                        if (KIND == 1) {
#pragma unroll
                            for (int j = 0; j < 4; ++j) { v0[j] = sigmoidf_(v0[j]); v1[j] = sigmoidf_(v1[j]); } }
                        u32x4 w; w.x = pg8::cvt_pk_bf16(v0[0], v0[1]); w.y = pg8::cvt_pk_bf16(v0[2], v0[3]); w.z = pg8::cvt_pk_bf16(v1[0], v1[1]); w.w = pg8::cvt_pk_bf16(v1[2], v1[3]);
                        *(u32x4*)((KIND == 1 ? ab : gb) + off) = w; }
                    asm volatile("" ::: "memory");
                }
        }
    }
};
struct EpiGate {
    static constexpr bool PERM = true, AFTER_DRAIN = false;
    bf16_t* Y; float* part;
    __device__ __forceinline__ void operator()(const f32x4 (&acc)[2][2][4][2], const Unit& u, int wr, int wc, int fr, int fq) const {
        const int row0 = u.pm * 256 + wr * 64 + fr, b = u.pn >> 2, pc = u.pn & 3;
        const bf16_t* Yb = Y + (size_t)b * NT * DM;
#pragma unroll
        for (int ai = 0; ai < 2; ++ai)
#pragma unroll
            for (int m = 0; m < 4; ++m)
#pragma unroll
                for (int bj = 0; bj < 2; ++bj) { const size_t off = (size_t)(row0 + ai * 128 + m * 16) * DM + pc * 256 + bj * 128 + wc * 32 + 8 * fq;
                    const u32x4 y = *(const u32x4*)(Yb + off); float o[8];
                    const float yv[8] = {bf_lo(y.x), bf_hi(y.x), bf_lo(y.y), bf_hi(y.y), bf_lo(y.z), bf_hi(y.z), bf_lo(y.w), bf_hi(y.w)};
#pragma unroll
                    for (int n = 0; n < 2; ++n)
#pragma unroll
                        for (int j = 0; j < 4; ++j) o[n * 4 + j] = sigmoidf_(acc[ai][bj][m][n][j]) * yv[n * 4 + j];
                    if (b > 0) { const u32x4 q = *(const u32x4*)(Y + off);
                        o[0] += bf_lo(q.x); o[1] += bf_hi(q.x); o[2] += bf_lo(q.y); o[3] += bf_hi(q.y); o[4] += bf_lo(q.z); o[5] += bf_hi(q.z); o[6] += bf_lo(q.w); o[7] += bf_hi(q.w); }
                    u32x4 w; w.x = pg8::cvt_pk_bf16(o[0], o[1]); w.y = pg8::cvt_pk_bf16(o[2], o[3]); w.z = pg8::cvt_pk_bf16(o[4], o[5]); w.w = pg8::cvt_pk_bf16(o[6], o[7]);
                    *(u32x4*)(Y + off) = w;
                }
    }
};
struct EpiStoreQ {
    static constexpr bool PERM = true, AFTER_DRAIN = false;
    bf16_t* Qh; float* qs4;
    __device__ __forceinline__ void operator()(const f32x4 (&acc)[2][2][4][2], const Unit& u, int wr, int wc, int fr, int fq) const {
        const int row0 = u.pm * 256 + wr * 64 + fr; bf16_t* base = Qh + (size_t)u.pn * NT * 256;
#pragma unroll
        for (int ai = 0; ai < 2; ++ai)
#pragma unroll
            for (int m = 0; m < 4; ++m) { const int row = row0 + ai * 128 + m * 16; float sq = 0.f;
#pragma unroll
                for (int bj = 0; bj < 2; ++bj) { const f32x4 v0 = acc[ai][bj][m][0], v1 = acc[ai][bj][m][1]; u32x4 w;
                    w.x = pg8::cvt_pk_bf16(v0[0], v0[1]); w.y = pg8::cvt_pk_bf16(v0[2], v0[3]); w.z = pg8::cvt_pk_bf16(v1[0], v1[1]); w.w = pg8::cvt_pk_bf16(v1[2], v1[3]);
                    *(u32x4*)(base + (size_t)row * 256 + bj * 128 + wc * 32 + 8 * fq) = w;
                    sq += (v0[0] * v0[0] + v0[1] * v0[1]) + (v0[2] * v0[2] + v0[3] * v0[3]) + (v1[0] * v1[0] + v1[1] * v1[1]) + (v1[2] * v1[2] + v1[3] * v1[3]); }
                sq += __shfl_xor(sq, 16); sq += __shfl_xor(sq, 32);
                if (fq == 0) qs4[((size_t)u.pn * NT + row) * 4 + wc] = sq; }
    }
};
struct EpiScore {
    static constexpr bool PERM = true, AFTER_DRAIN = false;
    bf16_t* P; const float* qs4; float* rs4;
    __device__ __forceinline__ void operator()(const f32x4 (&acc)[2][2][4][2], const Unit& u, int wr, int wc, int fr, int fq) const {
        const int row0 = u.pm * 256 + wr * 64 + fr;
#pragma unroll
        for (int ai = 0; ai < 2; ++ai)
#pragma unroll
            for (int m = 0; m < 4; ++m) { const int R = row0 + ai * 128 + m * 16; const f32x4 s4 = *(const f32x4*)(qs4 + (size_t)R * 4);
                const float sc = rsqrtf(((s4.x + s4.y) + (s4.z + s4.w)) * (1.f / 256.f) + 1e-6f); float sum = 0.f;
#pragma unroll
                for (int bj = 0; bj < 2; ++bj) { float o[8];
#pragma unroll
                    for (int n = 0; n < 2; ++n)
#pragma unroll
                        for (int j = 0; j < 4; ++j) { const float ev = __expf(acc[ai][bj][m][n][j] * sc); o[n * 4 + j] = ev; sum += ev; }
                    u32x4 w; w.x = pg8::cvt_pk_bf16(o[0], o[1]); w.y = pg8::cvt_pk_bf16(o[2], o[3]); w.z = pg8::cvt_pk_bf16(o[4], o[5]); w.w = pg8::cvt_pk_bf16(o[6], o[7]);
                    *(u32x4*)(P + (size_t)R * 256 + bj * 128 + wc * 32 + 8 * fq) = w; }
                sum += __shfl_xor(sum, 16); sum += __shfl_xor(sum, 32);
                if (fq == 0) rs4[(size_t)R * 4 + wc] = sum; }
    }
};
struct EpiPV {
    static constexpr bool PERM = true, AFTER_DRAIN = false;
    bf16_t* O; const float* rs4;
    __device__ __forceinline__ void operator()(const f32x4 (&acc)[2][2][4][2], const Unit& u, int wr, int wc, int fr, int fq) const {
        const int row0 = u.pm * 256 + wr * 64 + fr;
#pragma unroll
        for (int ai = 0; ai < 2; ++ai)
#pragma unroll
            for (int m = 0; m < 4; ++m) { const int R = row0 + ai * 128 + m * 16; const f32x4 s4 = *(const f32x4*)(rs4 + (size_t)R * 4); const float inv = 1.0f / ((s4.x + s4.y) + (s4.z + s4.w)); const int hd = R >> 15, tok = R & 32767;
#pragma unroll
                for (int bj = 0; bj < 2; ++bj) { const f32x4 v0 = acc[ai][bj][m][0] * inv, v1 = acc[ai][bj][m][1] * inv; u32x4 w;
                    w.x = pg8::cvt_pk_bf16(v0[0], v0[1]); w.y = pg8::cvt_pk_bf16(v0[2], v0[3]); w.z = pg8::cvt_pk_bf16(v1[0], v1[1]); w.w = pg8::cvt_pk_bf16(v1[2], v1[3]);
                    *(u32x4*)(O + (size_t)tok * DM + hd * 256 + bj * 128 + wc * 32 + 8 * fq) = w; } }
    }
};
struct DiagOrder {
    int G, c;
    __device__ bool next(int i, Unit& u) const { const int v = (G & 7) ? c : (c & 7) * (G >> 3) + (c >> 3);
        const int L = i * G + v; if (L >= 512) return false; u.pm = L; u.pn = L >> 4; return true; }
    __device__ __forceinline__ void a_ready(const Unit&) const {}
    __device__ __forceinline__ void done(const Unit&) const {}
};
struct GateOrder {
    int G, c;
    __device__ bool next(int i, Unit& u) const { const int v = (G & 7) ? c : (c & 7) * (G >> 3) + (c >> 3);
        const int T = (i / 3) * G + v; if (T >= 512) return false; const int b = i % 3; u.pm = T >> 2; u.pn = b * 4 + (T & 3); return true; }
    __device__ __forceinline__ void a_ready(const Unit&) const {}
    __device__ __forceinline__ void done(const Unit&) const {}
};

template <class Epi> __device__ __forceinline__ void run_gemm(LAS unsigned char* lds, const bf16_t* A, const bf16_t* Bt, int M, int N, int K, const Epi& E) {
    pg8::Gemm g{A, Bt, M, N, K}; pg8::StaticOrder S; S.init(M, N, (int)gridDim.x, (int)blockIdx.x);
    pg8::gemm_phase<Epi, pg8::StaticOrder, true, true>(lds, g, S, E);
}

__device__ __forceinline__ void tr_item(const float* W, int ldw, int c0, int K, bf16_t* WT, int r0, LAS float* scr, int kb, int lane) {
    const int k0 = 64 * kb;
#pragma unroll
    for (int i = 0; i < 8; ++i) { const int kk = 8 * i + (lane >> 3); const f32x4 v = *(const f32x4*)(W + (size_t)(k0 + kk) * ldw + c0 + 4 * (lane & 7));
        LAS float* d = scr + kk * 33 + 4 * (lane & 7); d[0] = v.x; d[1] = v.y; d[2] = v.z; d[3] = v.w; }
    LDS_WAIT();
    const int c = lane >> 3;
#pragma unroll
    for (int j = 0; j < 4; ++j) { const int n = (lane & 7) + 8 * j; const LAS float* s = scr + (8 * c) * 33 + n;
        u32x4 o; o.x = pk2(s[0 * 33], s[1 * 33]); o.y = pk2(s[2 * 33], s[3 * 33]); o.z = pk2(s[4 * 33], s[5 * 33]); o.w = pk2(s[6 * 33], s[7 * 33]);
        *(u32x4*)(WT + (size_t)(r0 + n) * K + k0 + 8 * c) = o; }
    LDS_WAIT();
}
__device__ __forceinline__ void conv_job(LAS unsigned char* lds, const float* W, int ldw, int c0, int ncols, int K, bf16_t* WT, int mode, int rot) {
    const int tid = otid(), lane = tid & 63, wave = tid >> 6, NGW = gridDim.x * 8; int gw = blockIdx.x * 8 + wave + rot; while (gw >= NGW) gw -= NGW;
    LAS float* scr = (LAS float*)(lds + wave * 8448);
    const int nblk = ncols / 32, nitems = (K / 64) * nblk;
    for (int it = gw; it < nitems; it += NGW) { const int kb = it / nblk, nb = it % nblk;
        const int sc = mode ? (((nb >> 2) & 1) * DFF + 128 * (nb >> 3) + 32 * (nb & 3)) : (c0 + 32 * nb);
        tr_item(W, ldw, sc, K, WT, 32 * nb, scr, kb, lane); }
}
__device__ __forceinline__ void norm_rows(const float* src, const float* gain, bf16_t* dst, int nrows) {
    const int tid = otid(), lane = tid & 63, gw = blockIdx.x * 8 + (tid >> 6), NGW = gridDim.x * 8;
    f32x4 g[4];
#pragma unroll
    for (int j = 0; j < 4; ++j) g[j] = *((const f32x4*)gain + lane + 64 * j);
#pragma unroll 4
    for (int m = gw; m < nrows; m += NGW) {
        const f32x4* xr = (const f32x4*)(src + (size_t)m * DM) + lane; f32x4 v[4]; float s = 0.f;
#pragma unroll
        for (int j = 0; j < 4; ++j) { v[j] = xr[64 * j]; s += (v[j].x * v[j].x + v[j].y * v[j].y) + (v[j].z * v[j].z + v[j].w * v[j].w); }
        const float r = rsqrtf(wave_sum_fast(s) * (1.f / DM) + 1e-6f);
        u32x2* o8 = (u32x2*)(dst + (size_t)m * DM) + lane;
#pragma unroll
        for (int j = 0; j < 4; ++j) { u32x2 w; w.x = pk2(v[j].x * r * g[j].x, v[j].y * r * g[j].y); w.y = pk2(v[j].z * r * g[j].z, v[j].w * r * g[j].w); o8[64 * j] = w; }
    }
}

__device__ __forceinline__ void rw_prep(const bf16_t* prw, const float* mu, bf16_t* xr, bf16_t* xk, bf16_t* xv, bf16_t* ap) {
    const int tid = otid(), lane = tid & 63, gw = blockIdx.x * 8 + (tid >> 6), NGW = gridDim.x * 8;
#pragma unroll 2
    for (int m = gw; m < NT; m += NGW) {
        const int t = m & (SEQ - 1); const bf16_t* p = prw + (size_t)m * 1824;
#pragma unroll
        for (int k = 0; k < 4; ++k) { const int g = lane + 64 * k;
            if (g < 228) { const int c = 8 * g;
                float cur[8], prv[8]; ld8(p + c, cur);
                if (t) ld8(p - 1824 + c, prv); else {
#pragma unroll
                    for (int i = 0; i < 8; ++i) prv[i] = 0.f; }
                const f32x4 m0 = *(const f32x4*)(mu + c), m1 = *(const f32x4*)(mu + c + 4); const float mv[8] = {m0.x, m0.y, m0.z, m0.w, m1.x, m1.y, m1.z, m1.w};
                float x[8];
#pragma unroll
                for (int i = 0; i < 8; ++i) x[i] = cur[i] + (prv[i] - cur[i]) * mv[i];
                bf16_t* dst;
                if (c < 1536) dst = (c < 512 ? xr : (c < 1024 ? xk : xv)) + (size_t)m * 512 + (c & 511);
                else if (c < 1600) {
#pragma unroll
                    for (int i = 0; i < 8; ++i) x[i] = tanhf(x[i]);
                    dst = ap + (size_t)m * 384 + (c - 1536); }
                else if (c < 1664) dst = ap + (size_t)m * 384 + 64 + (c - 1600);
                else {
#pragma unroll
                    for (int i = 0; i < 8; ++i) x[i] = sigmoidf_(x[i]);
                    dst = ap + (size_t)m * 384 + 128 + (c - 1664); }
                u32x4 w; w.x = pk2(x[0], x[1]); w.y = pk2(x[2], x[3]); w.z = pk2(x[4], x[5]); w.w = pk2(x[6], x[7]);
                *(u32x4*)dst = w; } }
        if (lane < 12) *(u32x4*)(ap + (size_t)m * 384 + 288 + 8 * lane) = (u32x4){0u, 0u, 0u, 0u};
    }
}
struct RwP { const bf16_t *xr, *xk, *xv, *ab, *gb; const float* decay; const float *k_k, *k_a, *r_k, *ln_w, *ln_b; bf16_t* ya; };
struct RwOps { f32x4 r, w, k, a, b; float v; };
struct RwIn { u32x2 r, kx, v, a; f32x4 w; };
__device__ __forceinline__ float hex_sum(float v) { v += dpp_f<0xB1>(v); v += dpp_f<0x4E>(v); v += dpp_f<0x141>(v); v += dpp_f<0x140>(v); return v; }
__device__ __forceinline__ void rw_ld(RwOps& o, const LAS float* OPb, int t, int cg, int row) {
    const LAS float* base = OPb + t * 64 + 4 * cg;
    o.r = *(const LAS f32x4*)(base); o.w = *(const LAS f32x4*)(base + 1024); o.k = *(const LAS f32x4*)(base + 2048); o.a = *(const LAS f32x4*)(base + 4096); o.b = *(const LAS f32x4*)(base + 5120);
    o.v = OPb[3 * 1024 + t * 64 + row];
}
__device__ __forceinline__ float rw_step(f32x2v (&S)[2], const RwOps& o) {
    f32x2v s0 = S[0] * (f32x2v){o.a.x, o.a.y}; s0 += S[1] * (f32x2v){o.a.z, o.a.w};
    const float sa = hex_sum(s0.x + s0.y);
    const f32x2v t0 = (f32x2v){o.b.x, o.b.y} * sa + (f32x2v){o.k.x, o.k.y} * o.v, t1 = (f32x2v){o.b.z, o.b.w} * sa + (f32x2v){o.k.z, o.k.w} * o.v;
    S[0] = S[0] * (f32x2v){o.w.x, o.w.y} + t0; S[1] = S[1] * (f32x2v){o.w.z, o.w.w} + t1;
    f32x2v y0 = S[0] * (f32x2v){o.r.x, o.r.y}; y0 += S[1] * (f32x2v){o.r.z, o.r.w};
    return y0.x + y0.y;
}
__device__ __forceinline__ void rw_load_in(RwIn& G, const RwP& P, size_t idx) {
    G.r = *(const u32x2*)(P.xr + idx); G.kx = *(const u32x2*)(P.xk + idx); G.v = *(const u32x2*)(P.xv + idx); G.a = *(const u32x2*)(P.ab + idx); G.w = *(const f32x4*)(P.decay + idx);
}
__device__ __forceinline__ void rw_prep_chunk(const RwIn& G, LAS float* dst  , f32x4 kkc, f32x4 kac) {
    const f32x4 r = {bf_lo(G.r.x), bf_hi(G.r.x), bf_lo(G.r.y), bf_hi(G.r.y)}, kx = {bf_lo(G.kx.x), bf_hi(G.kx.x), bf_lo(G.kx.y), bf_hi(G.kx.y)};
    const f32x4 v = {bf_lo(G.v.x), bf_hi(G.v.x), bf_lo(G.v.y), bf_hi(G.v.y)}, a = {bf_lo(G.a.x), bf_hi(G.a.x), bf_lo(G.a.y), bf_hi(G.a.y)};
    f32x4 kk = kx * kkc; const float nrm = sqrtf(hex_sum((kk.x * kk.x + kk.y * kk.y) + (kk.z * kk.z + kk.w * kk.w))); kk = kk * __builtin_amdgcn_rcpf(fmaxf(nrm, 1e-12f));
    const f32x4 k2 = kx * ((a - 1.0f) * kac + 1.0f);
    *(LAS f32x4*)(dst) = r; *(LAS f32x4*)(dst + 1024) = G.w; *(LAS f32x4*)(dst + 2048) = k2; *(LAS f32x4*)(dst + 3072) = v; *(LAS f32x4*)(dst + 4096) = -kk; *(LAS f32x4*)(dst + 5120) = kk * a;
}
__device__ __forceinline__ float rw_ysum(const LAS float* yp) { const LAS f32x4* q = (const LAS f32x4*)yp; const f32x4 a = q[0], b = q[1], c = q[2], d = q[3];
    return ((a.x + a.y) + (a.z + a.w)) + ((b.x + b.y) + (b.z + b.w)) + ((c.x + c.y) + (c.z + c.w)) + ((d.x + d.y) + (d.z + d.w)); }
#define RW_BAR() do { asm volatile("s_waitcnt lgkmcnt(0)" ::: "memory"); __builtin_amdgcn_s_barrier(); asm volatile("" ::: "memory"); } while (0)
__device__ __forceinline__ void rw_scan(LAS unsigned char* lds, const RwP& P, int unit, bf16_t* yraw) {
    const int tid = otid(), rq = unit & 3, bh = unit >> 2, b = bh >> 3, h = bh & 7, lane = tid & 63, wave = __builtin_amdgcn_readfirstlane(tid >> 6), hw = wave - 4, col = h * 64 + lane;
    LAS float* OP = (LAS float*)lds; LAS float* Y = OP + 2 * 6144;
    constexpr int NC = SEQ / 16;
    if (wave < 4) {
        const int cg = lane & 15, rl = 4 * wave + (lane >> 4), row = 16 * rq + rl;
        f32x2v S[2]; S[0] = (f32x2v){0.f, 0.f}; S[1] = (f32x2v){0.f, 0.f};
        RW_BAR();
        for (int c = 0; c < NC; ++c) {
            const LAS float* OPb = OP + (c & 1) * 6144; LAS float* Yb = Y + (c & 1) * 4096 + rl * 16 + cg;
            RwOps A, B;
            rw_ld(A, OPb, 0, cg, row);
#pragma unroll
            for (int t = 0; t < 16; t += 2) {
                rw_ld(B, OPb, t + 1, cg, row);
                Yb[t * 256] = rw_step(S, A);
                if (t + 2 < 16) rw_ld(A, OPb, t + 2, cg, row);
                Yb[(t + 1) * 256] = rw_step(S, B);
            }
            RW_BAR();
        }
        RW_BAR();
    } else {
        const int ht = tid - 256, yt = ht >> 4, yr = ht & 15, cq = lane & 15, pt = 4 * hw + (lane >> 4);
        const f32x4 kkc = *(const f32x4*)(P.k_k + h * 64 + 4 * cq), kac = *(const f32x4*)(P.k_a + h * 64 + 4 * cq);
        bf16_t* ydst = yraw + (size_t)(b * SEQ + yt) * 512 + h * 64 + 16 * rq + yr;
        const size_t ibase = (size_t)(b * SEQ + pt) * 512 + h * 64 + 4 * cq; const int poff = pt * 64 + 4 * cq;
        RwIn G0, G1, G2;
        rw_load_in(G0, P, ibase);
        rw_prep_chunk(G0, OP + poff, kkc, kac);
        rw_load_in(G1, P, ibase + (size_t)1 * 16 * 512);
        rw_load_in(G2, P, ibase + (size_t)2 * 16 * 512);
        RW_BAR();
#define RW_ITER(c_, GLD, GUSE) if ((c_) < NC) { const int cc_ = (c_), bf = cc_ & 1; \
            if (cc_ + 3 < NC) rw_load_in(GLD, P, ibase + (size_t)(cc_ + 3) * 16 * 512); \
            if (cc_ > 0) ydst[(size_t)(cc_ - 1) * 16 * 512] = (bf16_t)f2bf(rw_ysum(Y + (bf ^ 1) * 4096 + ht * 16)); \
            if (cc_ + 1 < NC) rw_prep_chunk(GUSE, OP + (bf ^ 1) * 6144 + poff, kkc, kac); \
            RW_BAR(); }
        for (int c = 0; c < NC; c += 3) { RW_ITER(c, G0, G1) RW_ITER(c + 1, G1, G2) RW_ITER(c + 2, G2, G0) }
#undef RW_ITER
        RW_BAR();
        ydst[(size_t)(NC - 1) * 16 * 512] = (bf16_t)f2bf(rw_ysum(Y + ((NC - 1) & 1) * 4096 + ht * 16));
    }
    __syncthreads();
}
#undef RW_BAR
__device__ __forceinline__ float oct_sum(float v) { v += dpp_f<0xB1>(v); v += dpp_f<0x4E>(v); v += dpp_f<0x141>(v); return v; }
__device__ __forceinline__ void rw_post_pass(const RwP& P, const bf16_t* yraw) {
    const int tid = otid(), lane = tid & 63, gw = blockIdx.x * 8 + (tid >> 6), NGW = gridDim.x * 8, c0 = 8 * lane;
    float ka[8], rk[8], lw[8], lb[8];
#pragma unroll
    for (int j = 0; j < 8; ++j) { ka[j] = P.k_a[c0 + j]; rk[j] = P.r_k[c0 + j]; lw[j] = P.ln_w[c0 + j]; lb[j] = P.ln_b[c0 + j]; }
#pragma unroll 2
    for (int m = gw; m < NT; m += NGW) { const size_t idx = (size_t)m * 512 + c0;
        float y[8], r[8], kx[8], v[8], a[8], g[8]; ld8(yraw + idx, y); ld8(P.xr + idx, r); ld8(P.xk + idx, kx); ld8(P.xv + idx, v); ld8(P.ab + idx, a); ld8(P.gb + idx, g);
        float sb = 0.f, sy = 0.f;
#pragma unroll
        for (int j = 0; j < 8; ++j) { const float k2 = kx[j] * (1.0f + (a[j] - 1.0f) * ka[j]); sb += r[j] * k2 * rk[j]; sy += y[j]; }
        const float bonus = oct_sum(sb), mean = oct_sum(sy) * (1.f / 64.f); float sv = 0.f;
#pragma unroll
        for (int j = 0; j < 8; ++j) { y[j] -= mean; sv += y[j] * y[j]; }
        const float rstd = rsqrtf(oct_sum(sv) * (1.f / 64.f) + 64e-5f); float o[8];
#pragma unroll
        for (int j = 0; j < 8; ++j) o[j] = (y[j] * rstd * lw[j] + lb[j] + bonus * v[j]) * g[j];
        u32x4 w; w.x = pk2(o[0], o[1]); w.y = pk2(o[2], o[3]); w.z = pk2(o[4], o[5]); w.w = pk2(o[6], o[7]);
        *(u32x4*)(P.ya + idx) = w; }
}

typedef short bf16x8_t __attribute__((ext_vector_type(8)));
typedef float f32x16 __attribute__((ext_vector_type(16)));
__device__ __forceinline__ bf16x8_t pack8(float a0, float a1, float a2, float a3, float a4, float a5, float a6, float a7) {
    u32x4 pz;
    asm volatile("s_nop 0\n\tv_cvt_pk_bf16_f32 %0, %4, %5\n\tv_cvt_pk_bf16_f32 %1, %6, %7\n\tv_cvt_pk_bf16_f32 %2, %8, %9\n\tv_cvt_pk_bf16_f32 %3, %10, %11\n\ts_nop 1"
                 : "=&v"(pz.x), "=&v"(pz.y), "=&v"(pz.z), "=&v"(pz.w) : "v"(a0), "v"(a1), "v"(a2), "v"(a3), "v"(a4), "v"(a5), "v"(a6), "v"(a7));
    return __builtin_bit_cast(bf16x8_t, pz); }
struct DilRaw { u32x4 k[4], v[4], q[2]; };
__device__ __forceinline__ void dil_load(const bf16_t* pdr, int unit, DilRaw& R) {
    const int tid = otid();
    const int rn = unit & 31, h = (unit >> 5) & 7, g = (unit >> 8) % 3, bl = unit / 768;
    const int ld = 2 * g, d = 1 << ld, rr = rn & (d - 1), n = rn >> ld;
    const int qcol = g * 1536 + h * 64, rowbase = bl * SEQ;
    const int row = tid >> 1, hf = tid & 1, mp = 128 * (n - 1) + row;
    if (mp >= 0) { const bf16_t* src = pdr + (size_t)(rowbase + mp * d + rr) * 6144 + qcol + hf * 32;
#pragma unroll
        for (int i = 0; i < 4; ++i) { R.k[i] = *(const u32x4*)(src + 512 + 8 * i); R.v[i] = *(const u32x4*)(src + 1024 + 8 * i); } }
    else {
#pragma unroll
        for (int i = 0; i < 4; ++i) { R.k[i] = (u32x4){0u, 0u, 0u, 0u}; R.v[i] = (u32x4){0u, 0u, 0u, 0u}; } }
    const int q = tid >> 2, p = tid & 3; const bf16_t* qs = pdr + (size_t)(rowbase + (128 * n + q) * d + rr) * 6144 + qcol + 16 * p;
    R.q[0] = *(const u32x4*)qs; R.q[1] = *(const u32x4*)(qs + 8);
}
__device__ __forceinline__ void up8(const u32x4 u, float* f) { f[0] = bf_lo(u.x); f[1] = bf_hi(u.x); f[2] = bf_lo(u.y); f[3] = bf_hi(u.y); f[4] = bf_lo(u.z); f[5] = bf_hi(u.z); f[6] = bf_lo(u.w); f[7] = bf_hi(u.w); }
__device__ __forceinline__ void dil_unit(LAS unsigned char* lds, const bf16_t* pdr, int unit, const DilRaw& R, int next_unit, DilRaw& Rn, const float* gq, const float* gk, const float* dcos, const float* dsin, bf16_t* og, float* deng) {
    const int tid = otid();
    const int rn = unit & 31, h = (unit >> 5) & 7, g = (unit >> 8) % 3, bl = unit / 768;
    const int ld = 2 * g, d = 1 << ld, rr = rn & (d - 1), n = rn >> ld;
    LAS bf16_t* Qs = (LAS bf16_t*)lds; LAS bf16_t* Ks = Qs + 128 * 72; LAS bf16_t* Vt = Ks + 256 * 72; LAS float* Xc = (LAS float*)(Vt + 64 * 260);
    const int qcol = g * 1536 + h * 64, rowbase = bl * SEQ;
    {   const int row = tid >> 1, hf = tid & 1, mp = 128 * (n - 1) + row;
        float kf[32];
        if (mp >= 0) { const int tk = mp * d + rr;
#pragma unroll
            for (int i = 0; i < 4; ++i) up8(R.k[i], kf + 8 * i);
            float ss = 0.f;
#pragma unroll
            for (int i = 0; i < 32; ++i) ss += kf[i] * kf[i];
            ss += __shfl_xor(ss, 1);
            const float rs = rsqrtf(ss * (1.f / 64.f) + 1e-6f);
#pragma unroll
            for (int i = 0; i < 32; ++i) kf[i] = kf[i] * rs * gk[g * 64 + hf * 32 + i];
            if (hf == 0) {
#pragma unroll
                for (int i = 0; i < 8; ++i) { const float c = dcos[tk * 8 + i], s = dsin[tk * 8 + i], x1 = kf[i], x2 = kf[i + 8]; kf[i] = x1 * c - x2 * s; kf[i + 8] = x2 * c + x1 * s; } }
        } else {
#pragma unroll
            for (int i = 0; i < 32; ++i) kf[i] = 0.f;
        }
#pragma unroll
        for (int i = 0; i < 4; ++i) { u32x4 w; w.x = pk2(kf[8 * i], kf[8 * i + 1]); w.y = pk2(kf[8 * i + 2], kf[8 * i + 3]); w.z = pk2(kf[8 * i + 4], kf[8 * i + 5]); w.w = pk2(kf[8 * i + 6], kf[8 * i + 7]);
            *(LAS u32x4*)(Ks + row * 72 + hf * 32 + 8 * i) = w; }
#pragma unroll
        for (int i = 0; i < 4; ++i) { const unsigned vv[4] = {R.v[i].x, R.v[i].y, R.v[i].z, R.v[i].w};
#pragma unroll
            for (int x = 0; x < 4; ++x) { Vt[(hf * 32 + 8 * i + 2 * x) * 260 + row] = (bf16_t)(vv[x] & 0xffffu); Vt[(hf * 32 + 8 * i + 2 * x + 1) * 260 + row] = (bf16_t)(vv[x] >> 16); } }
    }
    {   const int q = tid >> 2, p = tid & 3, tq = (128 * n + q) * d + rr;
        float qf[16]; up8(R.q[0], qf); up8(R.q[1], qf + 8);
        float ss = 0.f;
#pragma unroll
        for (int i = 0; i < 16; ++i) ss += qf[i] * qf[i];
        ss += __shfl_xor(ss, 1); ss += __shfl_xor(ss, 2);
        const float rs = rsqrtf(ss * (1.f / 64.f) + 1e-6f) * 0.125f;
#pragma unroll
        for (int i = 0; i < 16; ++i) qf[i] = qf[i] * rs * gq[g * 64 + 16 * p + i];
        if (p == 0) {
#pragma unroll
            for (int i = 0; i < 8; ++i) { const float c = dcos[tq * 8 + i], s = dsin[tq * 8 + i], x1 = qf[i], x2 = qf[i + 8]; qf[i] = x1 * c - x2 * s; qf[i + 8] = x2 * c + x1 * s; } }
#pragma unroll
        for (int i = 0; i < 2; ++i) { u32x4 w; w.x = pk2(qf[8 * i], qf[8 * i + 1]); w.y = pk2(qf[8 * i + 2], qf[8 * i + 3]); w.z = pk2(qf[8 * i + 4], qf[8 * i + 5]); w.w = pk2(qf[8 * i + 6], qf[8 * i + 7]);
            *(LAS u32x4*)(Qs + q * 72 + 16 * p + 8 * i) = w; }
    }
    __syncthreads();
    dil_load(pdr, next_unit, Rn);
    const int wv = __builtin_amdgcn_readfirstlane(tid >> 6), qt = wv & 3, kh = wv >> 2, lane = tid & 63, r = lane & 31, hh = lane >> 5;
    bf16x8_t qb[4];
#pragma unroll
    for (int ks = 0; ks < 4; ++ks) qb[ks] = *(const LAS bf16x8_t*)(Qs + (32 * qt + r) * 72 + 16 * ks + 8 * hh);
    f32x16 y0, y1; float den = 0.f;
#pragma unroll
    for (int i = 0; i < 16; ++i) { y0[i] = 0.f; y1[i] = 0.f; }
    const int qi = 32 * qt + r;
    for (int k4 = 0; k4 < 4; ++k4) { const int kt = 4 * kh + k4;
        if (kt < qt || kt > qt + 4) continue;
        f32x16 x;
#pragma unroll
        for (int i = 0; i < 16; ++i) x[i] = 0.f;
#pragma unroll
        for (int ks = 0; ks < 4; ++ks) { const bf16x8_t ka = *(const LAS bf16x8_t*)(Ks + (32 * kt + r) * 72 + 16 * ks + 8 * hh); x = __builtin_amdgcn_mfma_f32_32x32x16_bf16(ka, qb[ks], x, 0, 0, 0); }
#pragma unroll
        for (int i = 0; i < 16; ++i) { const int ki = 32 * kt + (i & 3) + 8 * (i >> 2) + 4 * hh;
            const bool valid = (ki >= qi) && (ki <= qi + 128) && (n > 0 || ki >= 128);
            const float e = valid ? __expf(x[i]) : 0.f; den += e; x[i] = e; }
#pragma unroll
        for (int s = 0; s < 2; ++s) { const bf16x8_t xs = pack8(x[8 * s], x[8 * s + 1], x[8 * s + 2], x[8 * s + 3], x[8 * s + 4], x[8 * s + 5], x[8 * s + 6], x[8 * s + 7]);
            const int kcol = 32 * kt + 16 * s + 4 * hh;
            {   const u32x2 lo = *(const LAS u32x2*)(Vt + r * 260 + kcol), hi = *(const LAS u32x2*)(Vt + r * 260 + kcol + 8); u32x4 v4; v4.x = lo.x; v4.y = lo.y; v4.z = hi.x; v4.w = hi.y;
                y0 = __builtin_amdgcn_mfma_f32_32x32x16_bf16(__builtin_bit_cast(bf16x8_t, v4), xs, y0, 0, 0, 0); }
            {   const u32x2 lo = *(const LAS u32x2*)(Vt + (32 + r) * 260 + kcol), hi = *(const LAS u32x2*)(Vt + (32 + r) * 260 + kcol + 8); u32x4 v4; v4.x = lo.x; v4.y = lo.y; v4.z = hi.x; v4.w = hi.y;
                y1 = __builtin_amdgcn_mfma_f32_32x32x16_bf16(__builtin_bit_cast(bf16x8_t, v4), xs, y1, 0, 0, 0); }
        }
    }
    den += __shfl_xor(den, 32);
    LAS float* xc = Xc + (qt * 64 + lane) * 33;
    if (kh == 1) {
#pragma unroll
        for (int i = 0; i < 16; ++i) { xc[i] = y0[i]; xc[16 + i] = y1[i]; }
        xc[32] = den; }
    __syncthreads();
    if (kh == 0) {
#pragma unroll
        for (int i = 0; i < 16; ++i) { y0[i] += xc[i]; y1[i] += xc[16 + i]; }
        den += xc[32];
        const float inv = 1.0f / den; const int tq = (128 * n + qi) * d + rr; const size_t orow = (size_t)g * CH + rowbase + tq;
        bf16_t* dst = og + orow * 512 + h * 64 + 4 * hh;
#pragma unroll
        for (int gI = 0; gI < 4; ++gI) { u32x2 w0, w1; w0.x = pk2(y0[4 * gI] * inv, y0[4 * gI + 1] * inv); w0.y = pk2(y0[4 * gI + 2] * inv, y0[4 * gI + 3] * inv);
            w1.x = pk2(y1[4 * gI] * inv, y1[4 * gI + 1] * inv); w1.y = pk2(y1[4 * gI + 2] * inv, y1[4 * gI + 3] * inv);
            *(u32x2*)(dst + 8 * gI) = w0; *(u32x2*)(dst + 32 + 8 * gI) = w1; }
        if (hh == 0) deng[orow * 8 + h] = den;
    }
    __syncthreads();
}
__device__ __forceinline__ void dil_combine(const bf16_t* og, const float* deng, bf16_t* yb  ) {
    const int NI = CH * 64;
#pragma unroll 2
    for (int it = blockIdx.x * 512 + otid(); it < NI; it += gridDim.x * 512) { const int tok = it >> 6, c8 = (it & 63) * 8, h = c8 >> 6;
        const float d0 = deng[(size_t)tok * 8 + h], d1 = deng[((size_t)CH + tok) * 8 + h], d2 = deng[((size_t)2 * CH + tok) * 8 + h]; const float inv = 1.0f / (d0 + d1 + d2);
        float a[8], b[8], c[8]; ld8(og + (size_t)tok * 512 + c8, a); ld8(og + ((size_t)CH + tok) * 512 + c8, b); ld8(og + ((size_t)2 * CH + tok) * 512 + c8, c);
        float o[8];
#pragma unroll
        for (int i = 0; i < 8; ++i) o[i] = (d0 * a[i] + d1 * b[i] + d2 * c[i]) * inv;
        u32x4 w; w.x = pk2(o[0], o[1]); w.y = pk2(o[2], o[3]); w.z = pk2(o[4], o[5]); w.w = pk2(o[6], o[7]);
        *(u32x4*)(yb + (size_t)tok * 512 + c8) = w; }
}

__device__ __forceinline__ void ret_load_k(const bf16_t* src  , int t, int qq, const float* rcos, const float* rsin, float scale, float* o1, float* o2) {
    float x1[8], x2[8]; ld8(src + 8 * qq, x1); ld8(src + 32 + 8 * qq, x2);
#pragma unroll
    for (int e = 0; e < 8; ++e) { const float c = rcos[t * 32 + 8 * qq + e], s = rsin[t * 32 + 8 * qq + e]; o1[e] = (x1[e] * c - x2[e] * s) * scale; o2[e] = (x2[e] * c + x1[e] * s) * scale; }
}
__device__ __forceinline__ void retA_unit(LAS unsigned char* lds, const bf16_t* pdr, int unit, const float* rcos, const float* rsin, float* kvst) {
    const int tid = otid(), c = unit & 31, h = (unit >> 5) & 3, bl = unit >> 7;
    const float lg = logf(1.0f - exp2f(-5.0f - (float)h));
    LAS float* Ks = (LAS float*)lds; LAS float* Vs = Ks + 128 * 64;
    {   const int row = tid >> 2, qq = tid & 3, t = c * 128 + row; const bf16_t* src = pdr + (size_t)(bl * SEQ + t) * 6144 + 4608;
        float o1[8], o2[8]; ret_load_k(src + 256 + h * 64, t, qq, rcos, rsin, 0.125f * __expf(lg * (float)(127 - row)), o1, o2);
#pragma unroll
        for (int e = 0; e < 8; ++e) { Ks[row * 64 + 8 * qq + e] = o1[e]; Ks[row * 64 + 32 + 8 * qq + e] = o2[e]; }
#pragma unroll
        for (int i = 0; i < 4; ++i) { float v[8]; ld8(src + 512 + h * 128 + 32 * qq + 8 * i, v);
            *(LAS f32x4*)(Vs + row * 128 + 32 * qq + 8 * i) = (f32x4){v[0], v[1], v[2], v[3]}; *(LAS f32x4*)(Vs + row * 128 + 32 * qq + 8 * i + 4) = (f32x4){v[4], v[5], v[6], v[7]}; }
    }
    __syncthreads();
    const int dd = tid >> 3, e0 = (tid & 7) * 16;
    f32x4 a0 = {0.f, 0.f, 0.f, 0.f}, a1 = a0, a2 = a0, a3 = a0;
    for (int j = 0; j < 128; ++j) { const float kd = Ks[j * 64 + dd]; const LAS f32x4* vr = (const LAS f32x4*)(Vs + j * 128 + e0);
        a0 += vr[0] * kd; a1 += vr[1] * kd; a2 += vr[2] * kd; a3 += vr[3] * kd; }
    float* dst = kvst + (size_t)unit * 8192 + dd * 128 + e0;
    *(f32x4*)dst = a0; *(f32x4*)(dst + 4) = a1; *(f32x4*)(dst + 8) = a2; *(f32x4*)(dst + 12) = a3;
    __syncthreads();
}
__device__ __forceinline__ void retC_unit(LAS unsigned char* lds, const bf16_t* pdr, int unit, const float* rcos, const float* rsin, const float* kvst, const float* gain, bf16_t* yc  ) {
    const int tid = otid(), lane = tid & 63, c = unit & 31, h = (unit >> 5) & 3, bl = unit >> 7;
    const float lg = logf(1.0f - exp2f(-5.0f - (float)h)), gC = __expf(lg * 128.0f);
    LAS bf16_t* Qs = (LAS bf16_t*)lds; LAS bf16_t* Ks = Qs + 128 * 72; LAS bf16_t* Vt = Ks + 128 * 72; LAS bf16_t* St = Vt + 128 * 132; LAS float* Xc = (LAS float*)(St + 128 * 72);
    {
        f32x4 s0 = {0.f, 0.f, 0.f, 0.f}, s1 = s0, s2 = s0, s3 = s0;
        const float* kp = kvst + (size_t)(unit - c) * 8192 + tid * 16;
        int cc = 0;
        for (; cc + 4 <= c; cc += 4) { f32x4 kq[4][4];
#pragma unroll
            for (int q = 0; q < 4; ++q) { const f32x4* k4 = (const f32x4*)(kp + (size_t)(cc + q) * 8192); kq[q][0] = k4[0]; kq[q][1] = k4[1]; kq[q][2] = k4[2]; kq[q][3] = k4[3]; }
#pragma unroll
            for (int q = 0; q < 4; ++q) { s0 = s0 * gC + kq[q][0]; s1 = s1 * gC + kq[q][1]; s2 = s2 * gC + kq[q][2]; s3 = s3 * gC + kq[q][3]; } }
        for (; cc < c; ++cc) { const f32x4* k4 = (const f32x4*)(kp + (size_t)cc * 8192); s0 = s0 * gC + k4[0]; s1 = s1 * gC + k4[1]; s2 = s2 * gC + k4[2]; s3 = s3 * gC + k4[3]; }
        const int dd = tid >> 3, e0 = (tid & 7) * 16; const float sv[16] = {s0.x, s0.y, s0.z, s0.w, s1.x, s1.y, s1.z, s1.w, s2.x, s2.y, s2.z, s2.w, s3.x, s3.y, s3.z, s3.w};
#pragma unroll
        for (int x = 0; x < 16; ++x) St[(e0 + x) * 72 + dd] = (bf16_t)f2bf(sv[x]);
        const int row = tid >> 2, qq = tid & 3, t = c * 128 + row; const bf16_t* src = pdr + (size_t)(bl * SEQ + t) * 6144 + 4608;
        float o1[8], o2[8];
        ret_load_k(src + 256 + h * 64, t, qq, rcos, rsin, 0.125f, o1, o2);
        *(LAS u32x4*)(Ks + row * 72 + 8 * qq) = (u32x4){pk2(o1[0], o1[1]), pk2(o1[2], o1[3]), pk2(o1[4], o1[5]), pk2(o1[6], o1[7])};
        *(LAS u32x4*)(Ks + row * 72 + 32 + 8 * qq) = (u32x4){pk2(o2[0], o2[1]), pk2(o2[2], o2[3]), pk2(o2[4], o2[5]), pk2(o2[6], o2[7])};
        ret_load_k(src + h * 64, t, qq, rcos, rsin, 1.0f, o1, o2);
        *(LAS u32x4*)(Qs + row * 72 + 8 * qq) = (u32x4){pk2(o1[0], o1[1]), pk2(o1[2], o1[3]), pk2(o1[4], o1[5]), pk2(o1[6], o1[7])};
        *(LAS u32x4*)(Qs + row * 72 + 32 + 8 * qq) = (u32x4){pk2(o2[0], o2[1]), pk2(o2[2], o2[3]), pk2(o2[4], o2[5]), pk2(o2[6], o2[7])};
#pragma unroll
        for (int i = 0; i < 4; ++i) { const u32x4 v = *(const u32x4*)(src + 512 + h * 128 + 32 * qq + 8 * i); const unsigned vv[4] = {v.x, v.y, v.z, v.w};
#pragma unroll
            for (int x = 0; x < 4; ++x) { Vt[(32 * qq + 8 * i + 2 * x) * 132 + row] = (bf16_t)(vv[x] & 0xffffu); Vt[(32 * qq + 8 * i + 2 * x + 1) * 132 + row] = (bf16_t)(vv[x] >> 16); } }
    }
    __syncthreads();
    const int wv = __builtin_amdgcn_readfirstlane(tid >> 6), qt = wv & 3, eh = wv >> 2, r = lane & 31, hh = lane >> 5, qi = 32 * qt + r;
    bf16x8_t qb[4], qc[4];
    {   const float qd = __expf(lg * (float)(qi + 1));
#pragma unroll
        for (int ks = 0; ks < 4; ++ks) { const u32x4 u = *(const LAS u32x4*)(Qs + qi * 72 + 16 * ks + 8 * hh); qb[ks] = __builtin_bit_cast(bf16x8_t, u);
            qc[ks] = pack8(bf_lo(u.x) * qd, bf_hi(u.x) * qd, bf_lo(u.y) * qd, bf_hi(u.y) * qd, bf_lo(u.z) * qd, bf_hi(u.z) * qd, bf_lo(u.w) * qd, bf_hi(u.w) * qd); }
    }
    f32x16 y0, y1;
#pragma unroll
    for (int i = 0; i < 16; ++i) { y0[i] = 0.f; y1[i] = 0.f; }
    const int er0 = (64 * eh + r) * 132, er1 = (64 * eh + 32 + r) * 132;
    for (int kt = 0; kt <= qt; ++kt) {
        f32x16 x;
#pragma unroll
        for (int i = 0; i < 16; ++i) x[i] = 0.f;
#pragma unroll
        for (int ks = 0; ks < 4; ++ks) { const bf16x8_t ka = *(const LAS bf16x8_t*)(Ks + (32 * kt + r) * 72 + 16 * ks + 8 * hh); x = __builtin_amdgcn_mfma_f32_32x32x16_bf16(ka, qb[ks], x, 0, 0, 0); }
#pragma unroll
        for (int i = 0; i < 16; ++i) { const int j = 32 * kt + (i & 3) + 8 * (i >> 2) + 4 * hh; x[i] = (j <= qi) ? x[i] * __expf(lg * (float)(qi - j)) : 0.f; }
#pragma unroll
        for (int s = 0; s < 2; ++s) { const bf16x8_t xs = pack8(x[8 * s], x[8 * s + 1], x[8 * s + 2], x[8 * s + 3], x[8 * s + 4], x[8 * s + 5], x[8 * s + 6], x[8 * s + 7]);
            const int kcol = 32 * kt + 16 * s + 4 * hh;
            {   const u32x2 lo = *(const LAS u32x2*)(Vt + er0 + kcol), hi = *(const LAS u32x2*)(Vt + er0 + kcol + 8); u32x4 v4; v4.x = lo.x; v4.y = lo.y; v4.z = hi.x; v4.w = hi.y;
                y0 = __builtin_amdgcn_mfma_f32_32x32x16_bf16(__builtin_bit_cast(bf16x8_t, v4), xs, y0, 0, 0, 0); }
            {   const u32x2 lo = *(const LAS u32x2*)(Vt + er1 + kcol), hi = *(const LAS u32x2*)(Vt + er1 + kcol + 8); u32x4 v4; v4.x = lo.x; v4.y = lo.y; v4.z = hi.x; v4.w = hi.y;
                y1 = __builtin_amdgcn_mfma_f32_32x32x16_bf16(__builtin_bit_cast(bf16x8_t, v4), xs, y1, 0, 0, 0); }
        }
    }
#pragma unroll
    for (int ks = 0; ks < 4; ++ks) {
        const bf16x8_t sa0 = *(const LAS bf16x8_t*)(St + (64 * eh + r) * 72 + 16 * ks + 8 * hh), sa1 = *(const LAS bf16x8_t*)(St + (64 * eh + 32 + r) * 72 + 16 * ks + 8 * hh);
        y0 = __builtin_amdgcn_mfma_f32_32x32x16_bf16(sa0, qc[ks], y0, 0, 0, 0); y1 = __builtin_amdgcn_mfma_f32_32x32x16_bf16(sa1, qc[ks], y1, 0, 0, 0); }
    float ss = 0.f;
#pragma unroll
    for (int i = 0; i < 16; ++i) ss += y0[i] * y0[i] + y1[i] * y1[i];
    ss += __shfl_xor(ss, 32);
    if (hh == 0) Xc[eh * 128 + qi] = ss;
    __syncthreads();
    const float rms = rsqrtf((Xc[qi] + Xc[128 + qi]) * (1.f / 128.f) + 1e-6f);
    const int t = c * 128 + qi; const bf16_t* gsrc = pdr + (size_t)(bl * SEQ + t) * 6144 + 4608 + 1024 + h * 128 + 64 * eh + 4 * hh;
    bf16_t* dst = yc + (size_t)(bl * SEQ + t) * 512 + h * 128 + 64 * eh + 4 * hh; const float* gn = gain + h * 128 + 64 * eh + 4 * hh;
#pragma unroll
    for (int gI = 0; gI < 4; ++gI) {
        {   const u32x2 gb = *(const u32x2*)(gsrc + 8 * gI); const f32x4 g4 = *(const f32x4*)(gn + 8 * gI); const float gv[4] = {bf_lo(gb.x), bf_hi(gb.x), bf_lo(gb.y), bf_hi(gb.y)}; float o[4];
#pragma unroll
            for (int x = 0; x < 4; ++x) o[x] = gv[x] * sigmoidf_(gv[x]) * (y0[4 * gI + x] * rms * g4[x]);
            u32x2 w; w.x = pk2(o[0], o[1]); w.y = pk2(o[2], o[3]); *(u32x2*)(dst + 8 * gI) = w; }
        {   const u32x2 gb = *(const u32x2*)(gsrc + 32 + 8 * gI); const f32x4 g4 = *(const f32x4*)(gn + 32 + 8 * gI); const float gv[4] = {bf_lo(gb.x), bf_hi(gb.x), bf_lo(gb.y), bf_hi(gb.y)}; float o[4];
#pragma unroll
            for (int x = 0; x < 4; ++x) o[x] = gv[x] * sigmoidf_(gv[x]) * (y1[4 * gI + x] * rms * g4[x]);
            u32x2 w; w.x = pk2(o[0], o[1]); w.y = pk2(o[2], o[3]); *(u32x2*)(dst + 32 + 8 * gI) = w; }
    }
    __syncthreads();
}

enum { I_X = 0, I_MEM, I_NORM_FFN1, I_FFN1_W13, I_FFN1_W2, I_NORM_MIX, I_W_IN, I_RW_MU, I_RW_W0, I_RW_W2, I_RW_A0, I_RW_A2, I_RW_G2, I_RW_KK, I_RW_KA, I_RW_RK, I_RW_LNW, I_RW_LNB,
       I_DIL_QN, I_DIL_KN, I_RET_NORM, I_WB_RWKV, I_WB_DIL, I_WB_RET, I_W_OUT, I_NORM_XA, I_NORM_MEM, I_XA_WQ, I_XA_WKV, I_XA_QN, I_XA_KN, I_XA_WO, I_NORM_FFN2, I_FFN2_W13, I_FFN2_W2, N_IN };
struct Args { const float* in[N_IN]; float* out; unsigned char* ws; };
typedef const float* fptr_t;
__device__ __forceinline__ fptr_t ld_in(int i) { const __attribute__((address_space(4))) fptr_t* p = (const __attribute__((address_space(4))) fptr_t*)__builtin_amdgcn_kernarg_segment_ptr(); asm volatile("" : "+s"(p)); return p[i]; }

#define XB_TMO      128
#define XB_XCNT(j)  (256  + 64 * (j))
#define XB_XSUB(j)  (1280 + 64 * (j))
#define XB_XGEN(j)  (2304 + 64 * (j))
#define XB_TOP      3328
#define XB_TOPGEN   3392
#define XCD_BAR_WORDS 3456
#define XB_SPIN_CAP (1u << 18)

__device__ __forceinline__ unsigned xb_ld(unsigned* p)              { return __hip_atomic_load(p, __ATOMIC_RELAXED, __HIP_MEMORY_SCOPE_AGENT); }
__device__ __forceinline__ unsigned xb_add(unsigned* p, unsigned v) { return __hip_atomic_fetch_add(p, v, __ATOMIC_RELAXED, __HIP_MEMORY_SCOPE_AGENT); }
__device__ __forceinline__ unsigned xb_xcc_id() { return (unsigned)__builtin_amdgcn_s_getreg((3 << 11) | 20) & 0xFu; }
#define XB_SPIN(cond, bar) do { unsigned _sp = 0; while (cond) { __builtin_amdgcn_s_sleep(1); \
    if ((++_sp & 255u) == 0u) { if (xb_ld(&(bar)[XB_TMO])) break; if (_sp > XB_SPIN_CAP) { atomicAdd(&(bar)[XB_TMO], 1u); break; } } } } while (0)

struct XcdBarrier {
    unsigned* bar; unsigned x;
    volatile LAS unsigned* st;
};

__device__ __forceinline__ XcdBarrier xcd_barrier_post(unsigned* bar, volatile LAS unsigned* st) {
    XcdBarrier b; b.bar = bar; b.x = xb_xcc_id(); b.st = st;
    if (threadIdx.x == 0) (void)xb_add(&bar[XB_XCNT(b.x)], 1u);
    return b;
}
__device__ __forceinline__ void xcd_barrier_complete(unsigned* bar, unsigned x, unsigned& nloc, unsigned& nx) {
    const unsigned G = gridDim.x * gridDim.y * gridDim.z;
    unsigned sum, cnt, mine, sp = 0u;
    for (;;) {
        sum = 0u; cnt = 0u; mine = 0u;
#pragma unroll
        for (unsigned j = 0; j < 16; ++j) { const unsigned c = xb_ld(&bar[XB_XCNT(j)]); sum += c; cnt += (c > 0u) ? 1u : 0u; mine = (j == x) ? c : mine; }
        if (sum == G) break;
        __builtin_amdgcn_s_sleep(1);
        if ((++sp & 255u) == 0u) { if (xb_ld(&bar[XB_TMO])) break; if (sp > XB_SPIN_CAP) { atomicAdd(&bar[XB_TMO], 1u); break; } }
    }
    nloc = mine > 0u ? mine : 1u; nx = cnt > 0u ? cnt : 1u;
}

__device__ __forceinline__ void xcd_barrier(const XcdBarrier& b) {
    asm volatile("s_waitcnt vmcnt(0)" ::: "memory");
    __syncthreads();
    if (threadIdx.x == 0) {
        unsigned* bar = b.bar;
        __builtin_amdgcn_s_waitcnt(0);
        unsigned nloc = b.st[0], nx = b.st[1];
        if (nloc == 0u) { xcd_barrier_complete(bar, b.x, nloc, nx); b.st[0] = nloc; b.st[1] = nx; }
        const unsigned old = xb_add(&bar[XB_XSUB(b.x)], 1u);
        const unsigned gen = old / nloc;
        if (old + 1u == (gen + 1u) * nloc) {
            __builtin_amdgcn_fence(__ATOMIC_RELEASE, "agent");
            asm volatile("s_waitcnt vmcnt(0)" ::: "memory");
            const unsigned og = xb_add(&bar[XB_TOP], 1u);
            const unsigned tg = og / nx;
            if (og + 1u == (tg + 1u) * nx) xb_add(&bar[XB_TOPGEN], 1u);
            else XB_SPIN(xb_ld(&bar[XB_TOPGEN]) == tg, bar);
            __builtin_amdgcn_fence(__ATOMIC_ACQUIRE, "agent");
            xb_add(&bar[XB_XGEN(b.x)], 1u);
            asm volatile("s_waitcnt vmcnt(0)" ::: "memory");
        } else {
            XB_SPIN(xb_ld(&bar[XB_XGEN(b.x)]) == gen, bar);
            __builtin_amdgcn_fence(__ATOMIC_ACQUIRE, "agent");
            asm volatile("s_waitcnt vmcnt(0)" ::: "memory");
        }
    }
    __syncthreads();
}

constexpr int XB_LDS_OFF = LDS_BYTES - 16;
__device__ __forceinline__ unsigned char* wsp(size_t off) { const __attribute__((address_space(4))) fptr_t* p = (const __attribute__((address_space(4))) fptr_t*)__builtin_amdgcn_kernarg_segment_ptr(); asm volatile("" : "+s"(p)); return (unsigned char*)p[N_IN + 1] + off; }
__device__ __forceinline__ float* ld_out() { const __attribute__((address_space(4))) fptr_t* p = (const __attribute__((address_space(4))) fptr_t*)__builtin_amdgcn_kernarg_segment_ptr(); asm volatile("" : "+s"(p)); return (float*)p[N_IN]; }
#define TP(mib) (wsp(WS_T + (size_t)(mib) * MiB))
#define WB ((bf16_t*)wsp(WS_WB))
#define KVB ((bf16_t*)wsp(WS_KV))
#define U ((bf16_t*)wsp(WS_U))
#define hbuf (ld_out())
#define dcos ((float*)wsp(WS_TAB))
#define dsin ((float*)wsp(WS_TAB) + SEQ * 8)
#define rcos ((float*)wsp(WS_TAB) + SEQ * 16)
#define rsin ((float*)wsp(WS_TAB) + SEQ * 48)
#define prw ((bf16_t*)TP(0))
#define xr ((bf16_t*)TP(114))
#define xk ((bf16_t*)TP(146))
#define xv ((bf16_t*)TP(178))
#define ap ((bf16_t*)TP(210))
#define decay ((float*)TP(0))
#define abuf ((bf16_t*)TP(64))
#define gbuf ((bf16_t*)TP(234))
#define ya ((bf16_t*)TP(266))
#define yb ((bf16_t*)TP(298))
#define yc ((bf16_t*)TP(330))
#define pdr ((bf16_t*)TP(0))
#define og ((bf16_t*)TP(192))
#define deng ((float*)TP(240))
#define kvst ((float*)TP(242))
#define Yb ((bf16_t*)TP(0))
#define part ((float*)TP(192))
#define Qh ((bf16_t*)TP(0))
#define rq ((float*)TP(64))
#define rs ((float*)TP(66))
#define Pm ((bf16_t*)TP(68))
#define Ob ((bf16_t*)TP(132))
#define FFA ((bf16_t*)TP(0))
__global__ void __launch_bounds__(512, 2) fwd_kernel(Args a) {
    extern __shared__ __attribute__((aligned(16))) unsigned char lds_raw[];
    LAS unsigned char* lds = (LAS unsigned char*)lds_raw;
    cg::grid_group grid = cg::this_grid();
    if (otid() < 4) ((LAS unsigned*)(lds + XB_LDS_OFF))[otid()] = 0u;
    __syncthreads();
    if (blockIdx.x == 0) for (int i = otid(); i < 4096; i += 512) ((unsigned*)wsp(0))[i] = 0u;
#define GSYNC() do { XcdBarrier b_; b_.bar = (unsigned*)wsp(0); b_.x = xb_xcc_id(); b_.st = (volatile LAS unsigned*)(lds + XB_LDS_OFF); xcd_barrier(b_); } while (0)
    const int G = gridDim.x, bx = blockIdx.x, GT = G * 512;
    const int vx = (G & 7) ? bx : (bx & 7) * (G >> 3) + (bx >> 3);
#define gtid (bx * 512 + otid())
#define lane (otid() & 63)
#define wave (otid() >> 6)

    for (int i = gtid; i < SEQ * 40; i += GT) {
        if (i < SEQ * 8) { const int t = i >> 3, k = i & 7; const float inv = powf(500000.0f, -(float)k / 8.0f); const float ang = (float)t * inv; dcos[i] = cosf(ang); dsin[i] = sinf(ang); }
        else { const int i2 = i - SEQ * 8, t = i2 >> 5, k = i2 & 31; const float inv = powf(10000.0f, -(float)k / 32.0f); const float ang = (float)t * inv; rcos[i2] = cosf(ang); rsin[i2] = sinf(ang); }
    }
    {   bf16_t* wkvt = (bf16_t*)TP(0);
        bf16_t* mn = (bf16_t*)TP(8);
        for (int l = 0; l < 2; ++l) {
            conv_job(lds, ld_in(I_XA_WKV) + (size_t)l * 1024 * 2048, 2048, 0, 2048, 1024, wkvt + (size_t)l * 2048 * 1024, 0, 0);
            norm_rows(ld_in(I_MEM), ld_in(I_NORM_MEM) + l * DM, mn + (size_t)l * 2048 * 1024, 2048);
        }
    }
    grid.sync();
    {   XcdBarrier b0 = xcd_barrier_post((unsigned*)wsp(0), (volatile LAS unsigned*)(lds + XB_LDS_OFF)); (void)b0; }
    {   bf16_t* wkvt = (bf16_t*)TP(0); bf16_t* mn = (bf16_t*)TP(8); float* kvraw = (float*)TP(330);
        for (int l = 0; l < 2; ++l) { EpiF32 E{kvraw + (size_t)l * 2048 * 2048, 2048}; run_gemm(lds, mn + (size_t)l * 2048 * 1024, wkvt + (size_t)l * 2048 * 1024, 2048, 2048, 1024, E); }
    }

    for (int l = 0; l < 2; ++l) {
        const float* hin = l == 0 ? ld_in(I_X) : hbuf;
        {   const float* w13a = ld_in(I_FFN1_W13) + (size_t)l * 1024 * 5632; const float* w2a = ld_in(I_FFN1_W2) + (size_t)l * 2816 * 1024;
            const float* w13b = ld_in(I_FFN2_W13) + (size_t)l * 1024 * 5632; const float* w2b = ld_in(I_FFN2_W2) + (size_t)l * 2816 * 1024;
            const float* win = ld_in(I_W_IN) + (size_t)l * 1024 * 11040;
            conv_job(lds, w13a, 5632, 0, 5632, 1024, WB + WO_W13A, 1, 0);
            conv_job(lds, w2a, 1024, 0, 1024, 2816, WB + WO_W2A, 0, 768);
            conv_job(lds, w13b, 5632, 0, 5632, 1024, WB + WO_W13B, 1, 128);
            conv_job(lds, w2b, 1024, 0, 1024, 2816, WB + WO_W2B, 0, 896);
            conv_job(lds, win, 11040, 0, 1824, 1024, WB + WO_RW, 0, 256);
            conv_job(lds, win, 11040, 1824, 6144, 1024, WB + WO_DR, 0, 1168);
            conv_job(lds, win, 11040, 7968, 3072, 1024, WB + WO_G, 0, 144);
            conv_job(lds, ld_in(I_WB_RWKV) + (size_t)l * 512 * 1024, 1024, 0, 1024, 512, WB + WO_BR, 0, 1680);
            conv_job(lds, ld_in(I_WB_DIL) + (size_t)l * 512 * 1024, 1024, 0, 1024, 512, WB + WO_BR + 1024 * 512, 0, 1936);
            conv_job(lds, ld_in(I_WB_RET) + (size_t)l * 512 * 1024, 1024, 0, 1024, 512, WB + WO_BR + 2 * 1024 * 512, 0, 144);
            conv_job(lds, ld_in(I_W_OUT) + (size_t)l * 1024 * 1024, 1024, 0, 1024, 1024, WB + WO_OUT, 0, 400);
            conv_job(lds, ld_in(I_XA_WQ) + (size_t)l * 1024 * 1024, 1024, 0, 1024, 1024, WB + WO_Q, 0, 912);
            conv_job(lds, ld_in(I_XA_WO) + (size_t)l * 1024 * 1024, 1024, 0, 1024, 1024, WB + WO_O, 0, 1424);
            { unsigned zz = 0u; asm volatile("" : "+v"(zz)); for (int i = gtid; i < 224 * 1024 / 8; i += GT) *((u32x4*)(WB + WO_RW + 1824 * 1024) + i) = (u32x4){zz, zz, zz, zz}; }
            const float* w2l = ld_in(I_RW_W2) + (size_t)l * 64 * 512; const float* a2l = ld_in(I_RW_A2) + (size_t)l * 64 * 512; const float* g2l = ld_in(I_RW_G2) + (size_t)l * 160 * 512;
            for (int i = gtid; i < 1536 * 384; i += GT) { const int n = i / 384, k = i - n * 384; float v = 0.f;
                if (n < 512) { if (k < 64) v = w2l[k * 512 + n]; }
                else if (n < 1024) { if (k >= 64 && k < 128) v = a2l[(k - 64) * 512 + n - 512]; }
                else { if (k >= 128 && k < 288) v = g2l[(k - 128) * 512 + n - 1024]; }
                WB[WO_LORA + i] = (bf16_t)f2bf(v); }
            norm_rows(hin, ld_in(I_NORM_FFN1) + l * DM, U, NT);
        }
        GSYNC();
        if (l == 0)
        {   const float* kvraw = (const float*)TP(330);
            for (int l = 0; l < 2; ++l) { const float* raw = kvraw + (size_t)l * 2048 * 2048; bf16_t* Kp = KVB + (size_t)l * 4 * 1024 * 1024; bf16_t* Vt = Kp + 2 * 1024 * 1024;
                const float* gq = ld_in(I_XA_QN) + l * 256; const float* gk = ld_in(I_XA_KN) + l * 256;
                for (int it = bx * 8 + wave; it < 2048 * 4; it += G * 8) { const int row = it >> 2, hd = it & 3, b = row >> 8, m = row & 255;
                    const f32x4 k4 = *(const f32x4*)(raw + (size_t)row * 2048 + hd * 256 + 4 * lane);
                    const float ss = wave_sum((k4.x * k4.x + k4.y * k4.y) + (k4.z * k4.z + k4.w * k4.w)); const float rk = rsqrtf(ss * (1.f / 256.f) + 1e-6f) * 0.0625f;
                    const f32x4 g1 = *(const f32x4*)(gq + 4 * lane), g2 = *(const f32x4*)(gk + 4 * lane);
                    u32x2 w; w.x = pk2(k4.x * rk * g1.x * g2.x, k4.y * rk * g1.y * g2.y); w.y = pk2(k4.z * rk * g1.z * g2.z, k4.w * rk * g1.w * g2.w);
                    *(u32x2*)(Kp + ((size_t)(hd * 8 + b) * 256 + m) * 256 + 4 * lane) = w; }
                {   LAS float* tl = (LAS float*)(lds + wave * 16640);
                    for (int tile = bx * 8 + wave; tile < 512; tile += G * 8) { const int hb = tile >> 4, mt = (tile >> 2) & 3, dt = tile & 3, hd = hb >> 3, b = hb & 7;
#pragma unroll 16
                        for (int r = 0; r < 64; ++r) tl[r * 65 + lane] = raw[(size_t)(b * 256 + 64 * mt + r) * 2048 + 1024 + hd * 256 + 64 * dt + lane];
                        LDS_WAIT();
#pragma unroll 16
                        for (int dd = 0; dd < 64; ++dd) Vt[(size_t)hb * 65536 + (size_t)(64 * dt + dd) * 256 + 64 * mt + lane] = (bf16_t)f2bf(tl[lane * 65 + dd]);
                        LDS_WAIT(); } }
            }
            __syncthreads();
        }
        {   EpiSwiglu E{FFA}; run_gemm(lds, U, WB + WO_W13A, NT, 5632, 1024, E); }
        GSYNC();
        {   EpiResid E{hin, hbuf, 0.5f}; run_gemm(lds, FFA, WB + WO_W2A, NT, 1024, DFF, E); }
        GSYNC();
        norm_rows(hbuf, ld_in(I_NORM_MIX) + l * DM, U, NT);
        GSYNC();
        {   EpiStore E{prw, 1824, 1824, 0, 0}; run_gemm(lds, U, WB + WO_RW, NT, 2048, 1024, E); }
        GSYNC();
        rw_prep(prw, ld_in(I_RW_MU) + l * 1824, xr, xk, xv, ap);
        GSYNC();
        {   EpiLora<0> E0{decay, abuf, gbuf, ld_in(I_RW_W0) + l * 512, ld_in(I_RW_A0) + l * 512}; run_gemm(lds, ap, WB + WO_LORA, NT, 512, 384, E0);
            EpiLora<1> E1{decay, abuf, gbuf, ld_in(I_RW_W0) + l * 512, ld_in(I_RW_A0) + l * 512}; run_gemm(lds, ap, WB + WO_LORA + 512 * 384, NT, 512, 384, E1);
            EpiLora<2> E2{decay, abuf, gbuf, ld_in(I_RW_W0) + l * 512, ld_in(I_RW_A0) + l * 512}; run_gemm(lds, ap, WB + WO_LORA + 1024 * 384, NT, 512, 384, E2); }
        GSYNC();
        {   RwP P{xr, xk, xv, abuf, gbuf, decay, ld_in(I_RW_KK) + l * 512, ld_in(I_RW_KA) + l * 512, ld_in(I_RW_RK) + l * 512, ld_in(I_RW_LNW) + l * 512, ld_in(I_RW_LNB) + l * 512, ya};
            for (int u = bx; u < 256; u += G) { const int x = u & 7, i = u >> 3; rw_scan(lds, P, ((x * 8 + (i >> 2)) << 2) | (i & 3), yb); } }
        GSYNC();
        {   RwP P{xr, xk, xv, abuf, gbuf, decay, ld_in(I_RW_KK) + l * 512, ld_in(I_RW_KA) + l * 512, ld_in(I_RW_RK) + l * 512, ld_in(I_RW_LNW) + l * 512, ld_in(I_RW_LNB) + l * 512, ya};
            rw_post_pass(P, yb); }
        GSYNC();
        {
            for (int ck = 0; ck < 2; ++ck) {
                {   EpiStore E{pdr, 6144, 6144, 0, 0}; run_gemm(lds, U + (size_t)ck * CH * DM, WB + WO_DR, CH, 6144, 1024, E); }
                GSYNC();
                {   DilRaw Ra, Rb; dil_load(pdr, vx < 3072 ? vx : 0, Ra);
                    for (int u = vx; u < 3072 + 512; u += G) {
                        if (u < 3072) { const int nu = u + G; dil_unit(lds, pdr, u, Ra, nu < 3072 ? nu : u, Rb, ld_in(I_DIL_QN) + l * 192, ld_in(I_DIL_KN) + l * 192, dcos, dsin, og, deng); Ra = Rb; }
                        else retA_unit(lds, pdr, u - 3072, rcos, rsin, kvst);
                    } }
                GSYNC();
                for (int u = vx; u < 512; u += G) retC_unit(lds, pdr, u, rcos, rsin, kvst, ld_in(I_RET_NORM) + l * 512, yc + (size_t)ck * CH * 512);
                dil_combine(og, deng, yb + (size_t)ck * CH * 512);
                GSYNC();
            }
        }
        {   for (int b = 0; b < 3; ++b) { EpiStore E{Yb + (size_t)b * NT * DM, DM, DM, 0, 0}; run_gemm(lds, b == 0 ? ya : (b == 1 ? yb : yc), WB + WO_BR + (size_t)b * 1024 * 512, NT, 1024, 512, E); } }
        GSYNC();
        {   EpiGate E{Yb, part}; pg8::Gemm g{U, WB + WO_G, NT, 3072, 1024}; GateOrder S{G, bx}; pg8::gemm_phase<EpiGate, GateOrder, true, true>(lds, g, S, E); }
        GSYNC();
        {   EpiResid E{hbuf, hbuf, 1.0f}; run_gemm(lds, Yb, WB + WO_OUT, NT, 1024, 1024, E); }
        GSYNC();
        norm_rows(hbuf, ld_in(I_NORM_XA) + l * DM, U, NT);
        GSYNC();
        {   EpiStoreQ E{Qh, rq}; run_gemm(lds, U, WB + WO_Q, NT, 1024, 1024, E); }
        GSYNC();
        {   const bf16_t* Kp = KVB + (size_t)l * 4 * 1024 * 1024; EpiScore E{Pm, rq, rs}; pg8::Gemm g{Qh, Kp, 4 * NT, 256, 256}; DiagOrder S{G, bx};
            pg8::gemm_phase<EpiScore, DiagOrder, true, true>(lds, g, S, E); }
        GSYNC();
        {   const bf16_t* Vt = KVB + (size_t)l * 4 * 1024 * 1024 + 2 * 1024 * 1024; EpiPV E{Ob, rs}; pg8::Gemm g{Pm, Vt, 4 * NT, 256, 256}; DiagOrder S{G, bx};
            pg8::gemm_phase<EpiPV, DiagOrder, true, true>(lds, g, S, E); }
        GSYNC();
        {   EpiResid E{hbuf, hbuf, 1.0f}; run_gemm(lds, Ob, WB + WO_O, NT, 1024, 1024, E); }
        GSYNC();
        norm_rows(hbuf, ld_in(I_NORM_FFN2) + l * DM, U, NT);
        GSYNC();
        {   EpiSwiglu E{FFA}; run_gemm(lds, U, WB + WO_W13B, NT, 5632, 1024, E); }
        GSYNC();
        {   EpiResid E{hbuf, hbuf, 0.5f}; run_gemm(lds, FFA, WB + WO_W2B, NT, 1024, DFF, E); }
        if (l == 0) GSYNC();
    }
}

#undef prw
#undef xr
#undef xk
#undef xv
#undef ap
#undef decay
#undef abuf
#undef gbuf
#undef ya
#undef yb
#undef yc
#undef pdr
#undef og
#undef deng
#undef kvst
#undef Yb
#undef part
#undef Qh
#undef rq
#undef rs
#undef Pm
#undef Ob
#undef FFA
#undef gtid
#undef lane
#undef wave
#undef TP
#undef WB
#undef KVB
#undef U
#undef hbuf
#undef dcos
#undef dsin
#undef rcos
#undef rsin
extern "C" void kernel_launch(void* const* d_in, const int* in_sizes, int n_in, void* d_out, int out_size, void* d_ws, size_t ws_size, hipStream_t stream) {
    static int grid = 0;
    if (grid == 0) {
        if (n_in != N_IN || ws_size < WS_END) { fprintf(stderr, "kernel_launch: unexpected n_in %d / ws_size %zu (need %zu)\n", n_in, ws_size, (size_t)WS_END); grid = -1; return; }
        int dev = 0, cus = 0, per_cu = 0;
        (void)hipGetDevice(&dev);
        (void)hipDeviceGetAttribute(&cus, hipDeviceAttributeMultiprocessorCount, dev);
        (void)hipFuncSetAttribute((const void*)fwd_kernel, hipFuncAttributeMaxDynamicSharedMemorySize, LDS_BYTES);
        (void)hipOccupancyMaxActiveBlocksPerMultiprocessor(&per_cu, (const void*)fwd_kernel, 512, LDS_BYTES);
        if (per_cu < 1) per_cu = 1;
        grid = cus * per_cu;
    }
    if (grid < 0) return;
    Args a{};
    for (int i = 0; i < N_IN; ++i) a.in[i] = (const float*)d_in[i];
    a.out = (float*)d_out; a.ws = (unsigned char*)d_ws;
    void* args[] = {&a};
    hipError_t e = hipLaunchCooperativeKernel((void*)fwd_kernel, dim3(grid), dim3(512), args, LDS_BYTES, stream);
    if (e != hipSuccess) fprintf(stderr, "cooperative launch failed: %s (grid %d)\n", hipGetErrorString(e), grid);
}
```

```cpp
#include <hip/hip_runtime.h>
#include <hip/hip_cooperative_groups.h>
#include <cstdio>
#include <cstdint>
namespace cg = cooperative_groups;
namespace pg8 {
#define PG8_LAS __attribute__((address_space(3)))
typedef unsigned short bf16_t;
typedef short bf16x8 __attribute__((ext_vector_type(8)));
typedef float f32x4 __attribute__((ext_vector_type(4)));
typedef unsigned u32x4 __attribute__((ext_vector_type(4)));
constexpr int BM = 256, BK = 64, HALF = 128, HTB = HALF * BK * 2  , STAGE_BYTES = 8 * HTB, NXCD = 8, WGM = 8;

__host__ __device__ __forceinline__ int lds_byte(int r, int c) { const int st = (r >> 4) * 2 + (c >> 5), rr = r & 15, cc = c & 31, ob = rr * 64 + cc * 2; return st * 1024 + (ob ^ (((ob >> 9) & 1) << 5)); }
__host__ __device__ __forceinline__ void stage_rc(int b, int& R, int& C) { const int st = b / 1024, sb = b % 1024, swz = sb ^ (((sb >> 9) & 1) << 5); R = (st >> 1) * 16 + swz / 64; C = (st & 1) * 32 + (swz % 64) / 2; }
__host__ __device__ __forceinline__ int perm32(int rho) { const int n = rho >> 4, i = rho & 15; return 8 * (i >> 2) + 4 * n + (i & 3); }

struct Unit { int pm, pn; };
struct Gemm { const bf16_t* A; const bf16_t* Bt; int M, N, K; };

struct StaticOrder {
    int nM, nN, nwg, G, c;
    __host__ __device__ void init(int M, int N, int G_, int c_) { nM = M / BM; nN = N / BM; nwg = nM * nN; G = G_; c = c_; }
    __host__ __device__ bool next(int i, Unit& u) const {
        const long L = (long)i * G + c; if (L >= nwg) return false;
        int wgid = (int)L; { const int q = nwg / NXCD, r = nwg % NXCD, xcd = wgid % NXCD, off = wgid / NXCD; wgid = (xcd < r ? xcd * (q + 1) : r * (q + 1) + (xcd - r) * q) + off; }
        const int nig = WGM * nN, gid = wgid / nig, fm = gid * WGM, gsz = (nM - fm) < WGM ? (nM - fm) : WGM;
        u.pm = fm + ((wgid % nig) % gsz); u.pn = (wgid % nig) / gsz; return true;
    }
    __device__ __forceinline__ void a_ready(const Unit&) const {}
    __device__ __forceinline__ void done(const Unit&) const {}
};

__device__ __forceinline__ unsigned cvt_pk_bf16(float lo, float hi) { unsigned r; asm volatile("s_nop 0\n\tv_cvt_pk_bf16_f32 %0, %1, %2" : "=v"(r) : "v"(lo), "v"(hi)); return r; }
typedef float f32x2 __attribute__((ext_vector_type(2)));
template <class Epi, class Sched, bool ALIGN_EPI = false, bool SP2 = false>
__device__ __forceinline__ void gemm_phase(PG8_LAS unsigned char* lds, const Gemm g, const Sched& S, const Epi& E) {
    int tid_ = threadIdx.x; asm volatile("" : "+v"(tid_));
    const int tid = tid_, wid = __builtin_amdgcn_readfirstlane(tid >> 6), lane = tid & 63, wr = wid >> 2, wc = wid & 3, fr = lane & 15, fq = lane >> 4;
    const int K = g.K, nt = K / BK;
    unsigned voffA[2], voffB[2];
#pragma unroll
    for (int i = 0; i < 2; ++i) { int R, C; stage_rc(tid * 16 + i * 8192, R, C); const int Rb = Epi::PERM ? ((R & ~31) + perm32(R & 31)) : R;
        voffA[i] = (unsigned)(R * K + C) * 2u; voffB[i] = (unsigned)(Rb * K + C) * 2u; }
    const size_t kstep = (size_t)(BK * 2);
    const size_t hstep = (size_t)HALF * K * 2;
    const size_t tstep = 2 * hstep;
    const unsigned ldsw = (unsigned)wid * 1024u;
    const int aoff = lds_byte(wr * 64 + fr, fq * 8), boff = lds_byte(wc * 32 + fr, fq * 8);
#define PG8_SA(b, h) (((b) * 2 + (h)) * HTB)
#define PG8_SB(b, h) ((4 + (b) * 2 + (h)) * HTB)
#define PG8_STAGE(bufoff, gbase, voff) do { _Pragma("unroll") for (int _i = 0; _i < 2; ++_i) \
        __builtin_amdgcn_global_load_lds((const unsigned*)((const char*)(gbase) + (voff)[_i]), (PG8_LAS unsigned*)(lds + (bufoff) + ldsw + _i * 8192), 16, 0, 0); } while (0)
#define PG8_LDA(dst, b, h) do { _Pragma("unroll") for (int m = 0; m < 4; ++m) _Pragma("unroll") for (int k = 0; k < 2; ++k) dst[m][k] = *(const PG8_LAS bf16x8*)(lds + PG8_SA(b, h) + aoff + m * 2048 + k * 1024); } while (0)
#define PG8_LDB(dst, b, h) do { _Pragma("unroll") for (int n = 0; n < 2; ++n) _Pragma("unroll") for (int k = 0; k < 2; ++k) dst[n][k] = *(const PG8_LAS bf16x8*)(lds + PG8_SB(b, h) + boff + n * 2048 + k * 1024); } while (0)
#define PG8_MMA(ai, bj, At, Bt) do { __builtin_amdgcn_s_setprio(1); _Pragma("unroll") for (int m = 0; m < 4; ++m) _Pragma("unroll") for (int n = 0; n < 2; ++n) _Pragma("unroll") for (int k = 0; k < 2; ++k) \
        acc[ai][bj][m][n] = __builtin_amdgcn_mfma_f32_16x16x32_bf16(Bt[n][k], At[m][k], acc[ai][bj][m][n], 0, 0, 0); __builtin_amdgcn_s_setprio(0); } while (0)
#define PG8_WAIT_V(n) asm volatile("s_waitcnt vmcnt(" #n ")" ::: "memory")
#define PG8_WAIT_L(n) asm volatile("s_waitcnt lgkmcnt(" #n ")" ::: "memory")
#define PG8_BAR __builtin_amdgcn_s_barrier()
#define PG8_SCHED __builtin_amdgcn_sched_barrier(0)
    Unit cur, nxt; int ui = 0;
    if (!S.next(0, cur)) return;
    f32x4 acc[2][2][4][2];
#pragma unroll
    for (int a = 0; a < 2; ++a)
#pragma unroll
        for (int b = 0; b < 2; ++b)
#pragma unroll
            for (int m = 0; m < 4; ++m)
#pragma unroll
                for (int n = 0; n < 2; ++n) acc[a][b][m][n] = (f32x4){0.f, 0.f, 0.f, 0.f};
    bf16x8 At[4][2], B0[2][2], B1[2][2];
    const char* cA = (const char*)g.A + (size_t)cur.pm * tstep; const char* cB = (const char*)g.Bt + (size_t)cur.pn * tstep;
    S.a_ready(cur);
    if constexpr (SP2) {
        PG8_STAGE(PG8_SB(0, 0), cB, voffB); PG8_STAGE(PG8_SB(0, 1), cB + hstep, voffB); PG8_STAGE(PG8_SA(0, 0), cA, voffA); PG8_STAGE(PG8_SA(0, 1), cA + hstep, voffA);
        if (wr == 1) PG8_BAR;
        PG8_WAIT_V(2); PG8_BAR;
        PG8_STAGE(PG8_SB(1, 0), cB + kstep, voffB); PG8_STAGE(PG8_SA(1, 0), cA + kstep, voffA); PG8_STAGE(PG8_SB(1, 1), cB + hstep + kstep, voffB);
        PG8_WAIT_V(6); PG8_BAR;
    } else {
        PG8_STAGE(PG8_SB(0, 0), cB, voffB); PG8_STAGE(PG8_SA(0, 0), cA, voffA); PG8_STAGE(PG8_SB(0, 1), cB + hstep, voffB); PG8_STAGE(PG8_SA(0, 1), cA + hstep, voffA);
        if (wr == 1) PG8_BAR;
        PG8_WAIT_V(4); PG8_BAR;
        PG8_STAGE(PG8_SB(1, 0), cB + kstep, voffB); PG8_STAGE(PG8_SA(1, 0), cA + kstep, voffA); PG8_STAGE(PG8_SB(1, 1), cB + hstep + kstep, voffB);
        PG8_WAIT_V(6); PG8_BAR;
    }
    for (;;) {
        const bool has_next = S.next(ui + 1, nxt);
        const char* nA = has_next ? (const char*)g.A + (size_t)nxt.pm * tstep : cA; const char* nB = has_next ? (const char*)g.Bt + (size_t)nxt.pn * tstep : cB;
#pragma unroll 1
        for (int t = 0; t < nt; t += 2) {
            const bool last = (t == nt - 2);
            const char* a1 = cA + (size_t)(t + 1) * kstep;
            const char* a2 = last ? nA : cA + (size_t)(t + 2) * kstep; const char* b2 = last ? nB : cB + (size_t)(t + 2) * kstep;
            const char* a3 = a2 + kstep; const char* b3 = b2 + kstep;
            if (last && has_next) S.a_ready(nxt);
            if constexpr (SP2) {
            PG8_LDB(B0, 0, 0); PG8_LDB(B1, 0, 1); PG8_SCHED; PG8_LDA(At, 0, 0); PG8_STAGE(PG8_SA(1, 1), a1 + hstep, voffA);
            PG8_WAIT_V(8); PG8_WAIT_L(0); PG8_BAR; PG8_MMA(0, 0, At, B0); PG8_MMA(0, 1, At, B1); PG8_BAR; PG8_SCHED;
            PG8_LDA(At, 0, 1); PG8_STAGE(PG8_SB(0, 0), b2, voffB); PG8_STAGE(PG8_SB(0, 1), b2 + hstep, voffB); PG8_STAGE(PG8_SA(0, 0), a2, voffA);
            PG8_WAIT_V(8); PG8_WAIT_L(0); PG8_BAR; PG8_MMA(1, 0, At, B0); PG8_MMA(1, 1, At, B1); PG8_BAR; PG8_SCHED;
            PG8_LDB(B0, 1, 0); PG8_LDB(B1, 1, 1); PG8_SCHED; PG8_LDA(At, 1, 0); PG8_STAGE(PG8_SA(0, 1), a2 + hstep, voffA);
            PG8_WAIT_V(8); PG8_WAIT_L(0); PG8_BAR; PG8_MMA(0, 0, At, B0); PG8_MMA(0, 1, At, B1); PG8_BAR; PG8_SCHED;
            PG8_LDA(At, 1, 1); PG8_STAGE(PG8_SB(1, 0), b3, voffB); PG8_STAGE(PG8_SB(1, 1), b3 + hstep, voffB); PG8_STAGE(PG8_SA(1, 0), a3, voffA);
            PG8_WAIT_V(8); PG8_WAIT_L(0); PG8_BAR; PG8_MMA(1, 0, At, B0); PG8_MMA(1, 1, At, B1); PG8_BAR; PG8_SCHED;
            } else {
            PG8_LDB(B0, 0, 0); PG8_SCHED; PG8_LDA(At, 0, 0); PG8_STAGE(PG8_SA(1, 1), a1 + hstep, voffA);
            PG8_WAIT_L(8); PG8_BAR; PG8_WAIT_L(0); PG8_MMA(0, 0, At, B0); PG8_BAR; PG8_SCHED;
            PG8_LDB(B1, 0, 1); PG8_STAGE(PG8_SB(0, 0), b2, voffB);
            PG8_BAR; PG8_WAIT_L(0); PG8_MMA(0, 1, At, B1); PG8_BAR;
            PG8_LDA(At, 0, 1); PG8_STAGE(PG8_SA(0, 0), a2, voffA);
            PG8_BAR; PG8_WAIT_L(0); PG8_MMA(1, 0, At, B0); PG8_BAR; PG8_SCHED;
            PG8_STAGE(PG8_SB(0, 1), b2 + hstep, voffB);
            PG8_WAIT_V(6); PG8_BAR; PG8_MMA(1, 1, At, B1); PG8_BAR;
            PG8_LDB(B0, 1, 0); PG8_SCHED; PG8_LDA(At, 1, 0); PG8_STAGE(PG8_SA(0, 1), a2 + hstep, voffA);
            PG8_WAIT_L(8); PG8_BAR; PG8_WAIT_L(0); PG8_MMA(0, 0, At, B0); PG8_BAR; PG8_SCHED;
            PG8_LDB(B1, 1, 1); PG8_STAGE(PG8_SB(1, 0), b3, voffB);
            PG8_BAR; PG8_WAIT_L(0); PG8_MMA(0, 1, At, B1); PG8_BAR;
            PG8_LDA(At, 1, 1); PG8_STAGE(PG8_SA(1, 0), a3, voffA);
            PG8_BAR; PG8_WAIT_L(0); PG8_MMA(1, 0, At, B0); PG8_BAR; PG8_SCHED;
            PG8_STAGE(PG8_SB(1, 1), b3 + hstep, voffB);
            PG8_WAIT_V(6); PG8_BAR; PG8_MMA(1, 1, At, B1); PG8_BAR;
            }
        }
        if constexpr (ALIGN_EPI) { if (wr == 0) PG8_BAR; }
        if constexpr (!Epi::AFTER_DRAIN) { E(acc, cur, wr, wc, fr, fq); S.done(cur); }
        if (!has_next) break;
#pragma unroll
        for (int a = 0; a < 2; ++a)
#pragma unroll
            for (int b = 0; b < 2; ++b)
#pragma unroll
                for (int m = 0; m < 4; ++m)
#pragma unroll
                    for (int n = 0; n < 2; ++n) acc[a][b][m][n] = (f32x4){0.f, 0.f, 0.f, 0.f};
        cur = nxt; cA = nA; cB = nB; ++ui;
        if constexpr (ALIGN_EPI) { if (wr == 1) PG8_BAR; }
    }
    PG8_WAIT_V(0);
    if constexpr (!ALIGN_EPI) { if (wr == 0) PG8_BAR; }
    PG8_BAR;
    if constexpr (Epi::AFTER_DRAIN) { E.fused(acc, cur, wr, wc, fr, fq, lds, wid, lane); S.done(cur); }
#undef PG8_SA
#undef PG8_SB
#undef PG8_STAGE
#undef PG8_LDA
#undef PG8_LDB
#undef PG8_MMA
#undef PG8_WAIT_V
#undef PG8_WAIT_L
#undef PG8_BAR
#undef PG8_SCHED
}
}

#define LAS __attribute__((address_space(3)))
typedef unsigned short bf16_t;
typedef float f32x4 __attribute__((ext_vector_type(4)));
typedef float f32x2v __attribute__((ext_vector_type(2)));
typedef unsigned u32x4 __attribute__((ext_vector_type(4)));
typedef unsigned u32x2 __attribute__((ext_vector_type(2)));

constexpr int NT = 32768, DM = 1024, SEQ = 4096, DFF = 2816;
constexpr int CH = 16384;
constexpr size_t MiB = 1u << 20;
constexpr int LDS_BYTES = 147456;

constexpr size_t WS_TAB = 1 * MiB;
constexpr size_t WS_WB = 4 * MiB;
constexpr size_t WS_KV = 70 * MiB;
constexpr size_t WS_U = 86 * MiB;
constexpr size_t WS_T = 150 * MiB;
constexpr size_t WS_END = 512 * MiB;
constexpr size_t WO_W13A = 0, WO_W2A = WO_W13A + 5632 * 1024, WO_W13B = WO_W2A + 1024 * 2816, WO_W2B = WO_W13B + 5632 * 1024,
                 WO_RW = WO_W2B + 1024 * 2816, WO_DR = WO_RW + 2048 * 1024, WO_G = WO_DR + 6144 * 1024, WO_LORA = WO_G + 3072 * 1024,
                 WO_BR = WO_LORA + 1536 * 384, WO_OUT = WO_BR + 3 * 1024 * 512, WO_Q = WO_OUT + 1024 * 1024, WO_O = WO_Q + 1024 * 1024, WO_ENDW = WO_O + 1024 * 1024;
static_assert(WO_ENDW * 2 <= 66 * MiB, "weights fit");

__device__ __forceinline__ float bf_lo(unsigned u) { return __uint_as_float(u << 16); }
__device__ __forceinline__ float bf_hi(unsigned u) { return __uint_as_float(u & 0xffff0000u); }
__device__ __forceinline__ float bf2f(bf16_t h) { return __uint_as_float((unsigned)h << 16); }
__device__ __forceinline__ unsigned pk2(float lo, float hi) { unsigned r; asm volatile("s_nop 0\n\tv_cvt_pk_bf16_f32 %0, %1, %2" : "=v"(r) : "v"(lo), "v"(hi)); return r; }
__device__ __forceinline__ unsigned f2bf(float f) { return pk2(f, 0.f) & 0xffffu; }
__device__ __forceinline__ float wave_sum(float v) {
#pragma unroll
    for (int o = 1; o < 64; o <<= 1) v += __shfl_xor(v, o);
    return v;
}
template <int CTRL> __device__ __forceinline__ float dpp_f(float v) { return __int_as_float(__builtin_amdgcn_update_dpp(0, __float_as_int(v), CTRL, 0xf, 0xf, true)); }
__device__ __forceinline__ float quad_sum(float v) { v += dpp_f<0xB1>(v); v += dpp_f<0x4E>(v); return v; }
__device__ __forceinline__ float wave_sum_fast(float v) {
    v = quad_sum(v); v += dpp_f<0x141>(v); v += dpp_f<0x140>(v);
    const float a = __int_as_float(__builtin_amdgcn_readlane(__float_as_int(v), 0)), b = __int_as_float(__builtin_amdgcn_readlane(__float_as_int(v), 16)),
                c = __int_as_float(__builtin_amdgcn_readlane(__float_as_int(v), 32)), d = __int_as_float(__builtin_amdgcn_readlane(__float_as_int(v), 48));
    return (a + b) + (c + d);
}
__device__ __forceinline__ float sigmoidf_(float x) { return __builtin_amdgcn_rcpf(1.0f + __expf(-x)); }
__device__ __forceinline__ void ld8(const bf16_t* p, float* f) { const u32x4 u = *(const u32x4*)p;
    f[0] = bf_lo(u.x); f[1] = bf_hi(u.x); f[2] = bf_lo(u.y); f[3] = bf_hi(u.y); f[4] = bf_lo(u.z); f[5] = bf_hi(u.z); f[6] = bf_lo(u.w); f[7] = bf_hi(u.w); }
#define LDS_WAIT() asm volatile("s_waitcnt lgkmcnt(0)" ::: "memory")
__device__ __forceinline__ int otid() { int t = threadIdx.x; asm volatile("" : "+v"(t)); return t; }

using pg8::Unit;
struct EpiStore {
    static constexpr bool PERM = true, AFTER_DRAIN = false;
    bf16_t* O; int ldc; int nvalid; int split_cols; size_t split_stride;
    __device__ __forceinline__ void operator()(const f32x4 (&acc)[2][2][4][2], const Unit& u, int wr, int wc, int fr, int fq) const {
        const int row0 = u.pm * 256 + wr * 64 + fr;
#pragma unroll
        for (int bj = 0; bj < 2; ++bj) {
            int c = u.pn * 256 + bj * 128 + wc * 32 + 8 * fq; if (c >= nvalid) continue;
            bf16_t* base = O; if (split_cols) { const int t = c / split_cols; base += (size_t)t * split_stride; c -= t * split_cols; }
#pragma unroll
            for (int ai = 0; ai < 2; ++ai)
#pragma unroll
                for (int m = 0; m < 4; ++m) { const f32x4 v0 = acc[ai][bj][m][0], v1 = acc[ai][bj][m][1]; u32x4 w;
                    w.x = pg8::cvt_pk_bf16(v0[0], v0[1]); w.y = pg8::cvt_pk_bf16(v0[2], v0[3]); w.z = pg8::cvt_pk_bf16(v1[0], v1[1]); w.w = pg8::cvt_pk_bf16(v1[2], v1[3]);
                    *(u32x4*)(base + (size_t)(row0 + ai * 128 + m * 16) * ldc + c) = w; }
        }
    }
};
struct EpiSwiglu {
    static constexpr bool PERM = true, AFTER_DRAIN = false;
    bf16_t* O;
    __device__ __forceinline__ void operator()(const f32x4 (&acc)[2][2][4][2], const Unit& u, int wr, int wc, int fr, int fq) const {
        const int row0 = u.pm * 256 + wr * 64 + fr, c = u.pn * 128 + wc * 32 + 8 * fq;
#pragma unroll
        for (int ai = 0; ai < 2; ++ai)
#pragma unroll
            for (int m = 0; m < 4; ++m) { float o[8];
#pragma unroll
                for (int n = 0; n < 2; ++n)
#pragma unroll
                    for (int j = 0; j < 4; ++j) { const float a = acc[ai][0][m][n][j], b = acc[ai][1][m][n][j]; o[n * 4 + j] = a * sigmoidf_(a) * b; }
                u32x4 w; w.x = pg8::cvt_pk_bf16(o[0], o[1]); w.y = pg8::cvt_pk_bf16(o[2], o[3]); w.z = pg8::cvt_pk_bf16(o[4], o[5]); w.w = pg8::cvt_pk_bf16(o[6], o[7]);
                *(u32x4*)(O + (size_t)(row0 + ai * 128 + m * 16) * DFF + c) = w; }
    }
};
struct EpiResid {
    static constexpr bool PERM = true, AFTER_DRAIN = false;
    const float* base; float* out; float scale;
    __device__ __forceinline__ void operator()(const f32x4 (&acc)[2][2][4][2], const Unit& u, int wr, int wc, int fr, int fq) const {
        const int row0 = u.pm * 256 + wr * 64 + fr;
#pragma unroll
        for (int ai = 0; ai < 2; ++ai)
#pragma unroll
            for (int m = 0; m < 4; ++m)
#pragma unroll
                for (int bj = 0; bj < 2; ++bj) { const size_t off = (size_t)(row0 + ai * 128 + m * 16) * DM + u.pn * 256 + bj * 128 + wc * 32 + 8 * fq;
                    const f32x4 b0 = *(const f32x4*)(base + off), b1 = *(const f32x4*)(base + off + 4);
                    *(f32x4*)(out + off) = b0 + acc[ai][bj][m][0] * scale; *(f32x4*)(out + off + 4) = b1 + acc[ai][bj][m][1] * scale; }
    }
};
struct EpiF32 {
    static constexpr bool PERM = true, AFTER_DRAIN = false;
    float* out; int ldc;
    __device__ __forceinline__ void operator()(const f32x4 (&acc)[2][2][4][2], const Unit& u, int wr, int wc, int fr, int fq) const {
        const int row0 = u.pm * 256 + wr * 64 + fr;
#pragma unroll
        for (int ai = 0; ai < 2; ++ai)
#pragma unroll
            for (int m = 0; m < 4; ++m)
#pragma unroll
                for (int bj = 0; bj < 2; ++bj) { const size_t off = (size_t)(row0 + ai * 128 + m * 16) * ldc + u.pn * 256 + bj * 128 + wc * 32 + 8 * fq;
                    *(f32x4*)(out + off) = acc[ai][bj][m][0]; *(f32x4*)(out + off + 4) = acc[ai][bj][m][1]; }
    }
};
template <int KIND> struct EpiLora {
    static constexpr bool PERM = true, AFTER_DRAIN = false;
    float* decay; bf16_t* ab; bf16_t* gb; const float* w0; const float* a0;
    __device__ __forceinline__ void operator()(const f32x4 (&acc)[2][2][4][2], const Unit& u, int wr, int wc, int fr, int fq) const {
        const int row0 = u.pm * 256 + wr * 64 + fr;
#pragma unroll
        for (int bj = 0; bj < 2; ++bj) {
            const int c = u.pn * 256 + bj * 128 + wc * 32 + 8 * fq;
            f32x4 b0 = {0.f, 0.f, 0.f, 0.f}, b1 = b0;
            if (KIND == 0) { b0 = *(const f32x4*)(w0 + c); b1 = *(const f32x4*)(w0 + c + 4); }
            if (KIND == 1) { b0 = *(const f32x4*)(a0 + c); b1 = *(const f32x4*)(a0 + c + 4); }
#pragma unroll
            for (int ai = 0; ai < 2; ++ai)
#pragma unroll
                for (int m = 0; m < 4; ++m) { const size_t off = (size_t)(row0 + ai * 128 + m * 16) * 512 + c;
                    f32x4 v0 = acc[ai][bj][m][0] + b0, v1 = acc[ai][bj][m][1] + b1;
                    if (KIND == 0) {
#pragma unroll
                        for (int j = 0; j < 4; ++j) {
                            v0[j] = __expf(-0.60653066f * sigmoidf_(v0[j])); v1[j] = __expf(-0.60653066f * sigmoidf_(v1[j])); }
                        *(f32x4*)(decay + off) = v0; *(f32x4*)(decay + off + 4) = v1;
                    } else {
                        if (KIND == 1) {
#pragma unroll
                            for (int j = 0; j < 4; ++j) { v0[j] = sigmoidf_(v0[j]); v1[j] = sigmoidf_(v1[j]); } }
                        u32x4 w; w.x = pg8::cvt_pk_bf16(v0[0], v0[1]); w.y = pg8::cvt_pk_bf16(v0[2], v0[3]); w.z = pg8::cvt_pk_bf16(v1[0], v1[1]); w.w = pg8::cvt_pk_bf16(v1[2], v1[3]);
                        *(u32x4*)((KIND == 1 ? ab : gb) + off) = w; }
                    asm volatile("" ::: "memory");
                }
        }
    }
};
struct EpiGate {
    static constexpr bool PERM = true, AFTER_DRAIN = false;
    bf16_t* Y; float* part;
    __device__ __forceinline__ void operator()(const f32x4 (&acc)[2][2][4][2], const Unit& u, int wr, int wc, int fr, int fq) const {
        const int row0 = u.pm * 256 + wr * 64 + fr, b = u.pn >> 2, pc = u.pn & 3;
        const bf16_t* Yb = Y + (size_t)b * NT * DM;
#pragma unroll
        for (int ai = 0; ai < 2; ++ai)
#pragma unroll
            for (int m = 0; m < 4; ++m)
#pragma unroll
                for (int bj = 0; bj < 2; ++bj) { const size_t off = (size_t)(row0 + ai * 128 + m * 16) * DM + pc * 256 + bj * 128 + wc * 32 + 8 * fq;
                    const u32x4 y = *(const u32x4*)(Yb + off); float o[8];
                    const float yv[8] = {bf_lo(y.x), bf_hi(y.x), bf_lo(y.y), bf_hi(y.y), bf_lo(y.z), bf_hi(y.z), bf_lo(y.w), bf_hi(y.w)};
#pragma unroll
                    for (int n = 0; n < 2; ++n)
#pragma unroll
                        for (int j = 0; j < 4; ++j) o[n * 4 + j] = sigmoidf_(acc[ai][bj][m][n][j]) * yv[n * 4 + j];
                    if (b > 0) { const u32x4 q = *(const u32x4*)(Y + off);
                        o[0] += bf_lo(q.x); o[1] += bf_hi(q.x); o[2] += bf_lo(q.y); o[3] += bf_hi(q.y); o[4] += bf_lo(q.z); o[5] += bf_hi(q.z); o[6] += bf_lo(q.w); o[7] += bf_hi(q.w); }
                    u32x4 w; w.x = pg8::cvt_pk_bf16(o[0], o[1]); w.y = pg8::cvt_pk_bf16(o[2], o[3]); w.z = pg8::cvt_pk_bf16(o[4], o[5]); w.w = pg8::cvt_pk_bf16(o[6], o[7]);
                    *(u32x4*)(Y + off) = w;
                }
    }
};
struct EpiStoreQ {
    static constexpr bool PERM = true, AFTER_DRAIN = false;
    bf16_t* Qh; float* qs4;
    __device__ __forceinline__ void operator()(const f32x4 (&acc)[2][2][4][2], const Unit& u, int wr, int wc, int fr, int fq) const {
        const int row0 = u.pm * 256 + wr * 64 + fr; bf16_t* base = Qh + (size_t)u.pn * NT * 256;
#pragma unroll
        for (int ai = 0; ai < 2; ++ai)
#pragma unroll
            for (int m = 0; m < 4; ++m) { const int row = row0 + ai * 128 + m * 16; float sq = 0.f;
#pragma unroll
                for (int bj = 0; bj < 2; ++bj) { const f32x4 v0 = acc[ai][bj][m][0], v1 = acc[ai][bj][m][1]; u32x4 w;
                    w.x = pg8::cvt_pk_bf16(v0[0], v0[1]); w.y = pg8::cvt_pk_bf16(v0[2], v0[3]); w.z = pg8::cvt_pk_bf16(v1[0], v1[1]); w.w = pg8::cvt_pk_bf16(v1[2], v1[3]);
                    *(u32x4*)(base + (size_t)row * 256 + bj * 128 + wc * 32 + 8 * fq) = w;
                    sq += (v0[0] * v0[0] + v0[1] * v0[1]) + (v0[2] * v0[2] + v0[3] * v0[3]) + (v1[0] * v1[0] + v1[1] * v1[1]) + (v1[2] * v1[2] + v1[3] * v1[3]); }
                sq += __shfl_xor(sq, 16); sq += __shfl_xor(sq, 32);
                if (fq == 0) qs4[((size_t)u.pn * NT + row) * 4 + wc] = sq; }
    }
};
struct EpiScore {
    static constexpr bool PERM = true, AFTER_DRAIN = false;
    bf16_t* P; const float* qs4; float* rs4;
    __device__ __forceinline__ void operator()(const f32x4 (&acc)[2][2][4][2], const Unit& u, int wr, int wc, int fr, int fq) const {
        const int row0 = u.pm * 256 + wr * 64 + fr;
#pragma unroll
        for (int ai = 0; ai < 2; ++ai)
#pragma unroll
            for (int m = 0; m < 4; ++m) { const int R = row0 + ai * 128 + m * 16; const f32x4 s4 = *(const f32x4*)(qs4 + (size_t)R * 4);
                const float sc = rsqrtf(((s4.x + s4.y) + (s4.z + s4.w)) * (1.f / 256.f) + 1e-6f); float sum = 0.f;
#pragma unroll
                for (int bj = 0; bj < 2; ++bj) { float o[8];
#pragma unroll
                    for (int n = 0; n < 2; ++n)
#pragma unroll
                        for (int j = 0; j < 4; ++j) { const float ev = __expf(acc[ai][bj][m][n][j] * sc); o[n * 4 + j] = ev; sum += ev; }
                    u32x4 w; w.x = pg8::cvt_pk_bf16(o[0], o[1]); w.y = pg8::cvt_pk_bf16(o[2], o[3]); w.z = pg8::cvt_pk_bf16(o[4], o[5]); w.w = pg8::cvt_pk_bf16(o[6], o[7]);
                    *(u32x4*)(P + (size_t)R * 256 + bj * 128 + wc * 32 + 8 * fq) = w; }
                sum += __shfl_xor(sum, 16); sum += __shfl_xor(sum, 32);
                if (fq == 0) rs4[(size_t)R * 4 + wc] = sum; }
    }
};
struct EpiPV {
    static constexpr bool PERM = true, AFTER_DRAIN = false;
    bf16_t* O; const float* rs4;
    __device__ __forceinline__ void operator()(const f32x4 (&acc)[2][2][4][2], const Unit& u, int wr, int wc, int fr, int fq) const {
        const int row0 = u.pm * 256 + wr * 64 + fr;
#pragma unroll
        for (int ai = 0; ai < 2; ++ai)
#pragma unroll
            for (int m = 0; m < 4; ++m) { const int R = row0 + ai * 128 + m * 16; const f32x4 s4 = *(const f32x4*)(rs4 + (size_t)R * 4); const float inv = 1.0f / ((s4.x + s4.y) + (s4.z + s4.w)); const int hd = R >> 15, tok = R & 32767;
#pragma unroll
                for (int bj = 0; bj < 2; ++bj) { const f32x4 v0 = acc[ai][bj][m][0] * inv, v1 = acc[ai][bj][m][1] * inv; u32x4 w;
                    w.x = pg8::cvt_pk_bf16(v0[0], v0[1]); w.y = pg8::cvt_pk_bf16(v0[2], v0[3]); w.z = pg8::cvt_pk_bf16(v1[0], v1[1]); w.w = pg8::cvt_pk_bf16(v1[2], v1[3]);
                    *(u32x4*)(O + (size_t)tok * DM + hd * 256 + bj * 128 + wc * 32 + 8 * fq) = w; } }
    }
};
struct DiagOrder {
    int G, c;
    __device__ bool next(int i, Unit& u) const { const int v = (G & 7) ? c : (c & 7) * (G >> 3) + (c >> 3);
        const int L = i * G + v; if (L >= 512) return false; u.pm = L; u.pn = L >> 4; return true; }
    __device__ __forceinline__ void a_ready(const Unit&) const {}
    __device__ __forceinline__ void done(const Unit&) const {}
};
struct GateOrder {
    int G, c;
    __device__ bool next(int i, Unit& u) const { const int v = (G & 7) ? c : (c & 7) * (G >> 3) + (c >> 3);
        const int T = (i / 3) * G + v; if (T >= 512) return false; const int b = i % 3; u.pm = T >> 2; u.pn = b * 4 + (T & 3); return true; }
    __device__ __forceinline__ void a_ready(const Unit&) const {}
    __device__ __forceinline__ void done(const Unit&) const {}
};

template <class Epi> __device__ __forceinline__ void run_gemm(LAS unsigned char* lds, const bf16_t* A, const bf16_t* Bt, int M, int N, int K, const Epi& E) {
    pg8::Gemm g{A, Bt, M, N, K}; pg8::StaticOrder S; S.init(M, N, (int)gridDim.x, (int)blockIdx.x);
    pg8::gemm_phase<Epi, pg8::StaticOrder, true, true>(lds, g, S, E);
}

__device__ __forceinline__ void tr_item(const float* W, int ldw, int c0, int K, bf16_t* WT, int r0, LAS float* scr, int kb, int lane) {
    const int k0 = 64 * kb;
#pragma unroll
    for (int i = 0; i < 8; ++i) { const int kk = 8 * i + (lane >> 3); const f32x4 v = *(const f32x4*)(W + (size_t)(k0 + kk) * ldw + c0 + 4 * (lane & 7));
        LAS float* d = scr + kk * 33 + 4 * (lane & 7); d[0] = v.x; d[1] = v.y; d[2] = v.z; d[3] = v.w; }
    LDS_WAIT();
    const int c = lane >> 3;
#pragma unroll
    for (int j = 0; j < 4; ++j) { const int n = (lane & 7) + 8 * j; const LAS float* s = scr + (8 * c) * 33 + n;
        u32x4 o; o.x = pk2(s[0 * 33], s[1 * 33]); o.y = pk2(s[2 * 33], s[3 * 33]); o.z = pk2(s[4 * 33], s[5 * 33]); o.w = pk2(s[6 * 33], s[7 * 33]);
        *(u32x4*)(WT + (size_t)(r0 + n) * K + k0 + 8 * c) = o; }
    LDS_WAIT();
}
__device__ __forceinline__ void conv_job(LAS unsigned char* lds, const float* W, int ldw, int c0, int ncols, int K, bf16_t* WT, int mode, int rot) {
    const int tid = otid(), lane = tid & 63, wave = tid >> 6, NGW = gridDim.x * 8; int gw = blockIdx.x * 8 + wave + rot; while (gw >= NGW) gw -= NGW;
    LAS float* scr = (LAS float*)(lds + wave * 8448);
    const int nblk = ncols / 32, nitems = (K / 64) * nblk;
    for (int it = gw; it < nitems; it += NGW) { const int kb = it / nblk, nb = it % nblk;
        const int sc = mode ? (((nb >> 2) & 1) * DFF + 128 * (nb >> 3) + 32 * (nb & 3)) : (c0 + 32 * nb);
        tr_item(W, ldw, sc, K, WT, 32 * nb, scr, kb, lane); }
}
__device__ __forceinline__ void norm_rows(const float* src, const float* gain, bf16_t* dst, int nrows) {
    const int tid = otid(), lane = tid & 63, gw = blockIdx.x * 8 + (tid >> 6), NGW = gridDim.x * 8;
    f32x4 g[4];
#pragma unroll
    for (int j = 0; j < 4; ++j) g[j] = *((const f32x4*)gain + lane + 64 * j);
#pragma unroll 4
    for (int m = gw; m < nrows; m += NGW) {
        const f32x4* xr = (const f32x4*)(src + (size_t)m * DM) + lane; f32x4 v[4]; float s = 0.f;
#pragma unroll
        for (int j = 0; j < 4; ++j) { v[j] = xr[64 * j]; s += (v[j].x * v[j].x + v[j].y * v[j].y) + (v[j].z * v[j].z + v[j].w * v[j].w); }
        const float r = rsqrtf(wave_sum_fast(s) * (1.f / DM) + 1e-6f);
        u32x2* o8 = (u32x2*)(dst + (size_t)m * DM) + lane;
#pragma unroll
        for (int j = 0; j < 4; ++j) { u32x2 w; w.x = pk2(v[j].x * r * g[j].x, v[j].y * r * g[j].y); w.y = pk2(v[j].z * r * g[j].z, v[j].w * r * g[j].w); o8[64 * j] = w; }
    }
}

__device__ __forceinline__ void rw_prep(const bf16_t* prw, const float* mu, bf16_t* xr, bf16_t* xk, bf16_t* xv, bf16_t* ap) {
    const int tid = otid(), lane = tid & 63, gw = blockIdx.x * 8 + (tid >> 6), NGW = gridDim.x * 8;
#pragma unroll 2
    for (int m = gw; m < NT; m += NGW) {
        const int t = m & (SEQ - 1); const bf16_t* p = prw + (size_t)m * 1824;
#pragma unroll
        for (int k = 0; k < 4; ++k) { const int g = lane + 64 * k;
            if (g < 228) { const int c = 8 * g;
                float cur[8], prv[8]; ld8(p + c, cur);
                if (t) ld8(p - 1824 + c, prv); else {
#pragma unroll
                    for (int i = 0; i < 8; ++i) prv[i] = 0.f; }
                const f32x4 m0 = *(const f32x4*)(mu + c), m1 = *(const f32x4*)(mu + c + 4); const float mv[8] = {m0.x, m0.y, m0.z, m0.w, m1.x, m1.y, m1.z, m1.w};
                float x[8];
#pragma unroll
                for (int i = 0; i < 8; ++i) x[i] = cur[i] + (prv[i] - cur[i]) * mv[i];
                bf16_t* dst;
                if (c < 1536) dst = (c < 512 ? xr : (c < 1024 ? xk : xv)) + (size_t)m * 512 + (c & 511);
                else if (c < 1600) {
#pragma unroll
                    for (int i = 0; i < 8; ++i) x[i] = tanhf(x[i]);
                    dst = ap + (size_t)m * 384 + (c - 1536); }
                else if (c < 1664) dst = ap + (size_t)m * 384 + 64 + (c - 1600);
                else {
#pragma unroll
                    for (int i = 0; i < 8; ++i) x[i] = sigmoidf_(x[i]);
                    dst = ap + (size_t)m * 384 + 128 + (c - 1664); }
                u32x4 w; w.x = pk2(x[0], x[1]); w.y = pk2(x[2], x[3]); w.z = pk2(x[4], x[5]); w.w = pk2(x[6], x[7]);
                *(u32x4*)dst = w; } }
        if (lane < 12) *(u32x4*)(ap + (size_t)m * 384 + 288 + 8 * lane) = (u32x4){0u, 0u, 0u, 0u};
    }
}
struct RwP { const bf16_t *xr, *xk, *xv, *ab, *gb; const float* decay; const float *k_k, *k_a, *r_k, *ln_w, *ln_b; bf16_t* ya; };
struct RwOps { f32x4 r, w, k, a, b; float v; };
struct RwIn { u32x2 r, kx, v, a; f32x4 w; };
__device__ __forceinline__ float hex_sum(float v) { v += dpp_f<0xB1>(v); v += dpp_f<0x4E>(v); v += dpp_f<0x141>(v); v += dpp_f<0x140>(v); return v; }
__device__ __forceinline__ void rw_ld(RwOps& o, const LAS float* OPb, int t, int cg, int row) {
    const LAS float* base = OPb + t * 64 + 4 * cg;
    o.r = *(const LAS f32x4*)(base); o.w = *(const LAS f32x4*)(base + 1024); o.k = *(const LAS f32x4*)(base + 2048); o.a = *(const LAS f32x4*)(base + 4096); o.b = *(const LAS f32x4*)(base + 5120);
    o.v = OPb[3 * 1024 + t * 64 + row];
}
__device__ __forceinline__ float rw_step(f32x2v (&S)[2], const RwOps& o) {
    f32x2v s0 = S[0] * (f32x2v){o.a.x, o.a.y}; s0 += S[1] * (f32x2v){o.a.z, o.a.w};
    const float sa = hex_sum(s0.x + s0.y);
    const f32x2v t0 = (f32x2v){o.b.x, o.b.y} * sa + (f32x2v){o.k.x, o.k.y} * o.v, t1 = (f32x2v){o.b.z, o.b.w} * sa + (f32x2v){o.k.z, o.k.w} * o.v;
    S[0] = S[0] * (f32x2v){o.w.x, o.w.y} + t0; S[1] = S[1] * (f32x2v){o.w.z, o.w.w} + t1;
    f32x2v y0 = S[0] * (f32x2v){o.r.x, o.r.y}; y0 += S[1] * (f32x2v){o.r.z, o.r.w};
    return y0.x + y0.y;
}
__device__ __forceinline__ void rw_load_in(RwIn& G, const RwP& P, size_t idx) {
    G.r = *(const u32x2*)(P.xr + idx); G.kx = *(const u32x2*)(P.xk + idx); G.v = *(const u32x2*)(P.xv + idx); G.a = *(const u32x2*)(P.ab + idx); G.w = *(const f32x4*)(P.decay + idx);
}
__device__ __forceinline__ void rw_prep_chunk(const RwIn& G, LAS float* dst  , f32x4 kkc, f32x4 kac) {
    const f32x4 r = {bf_lo(G.r.x), bf_hi(G.r.x), bf_lo(G.r.y), bf_hi(G.r.y)}, kx = {bf_lo(G.kx.x), bf_hi(G.kx.x), bf_lo(G.kx.y), bf_hi(G.kx.y)};
    const f32x4 v = {bf_lo(G.v.x), bf_hi(G.v.x), bf_lo(G.v.y), bf_hi(G.v.y)}, a = {bf_lo(G.a.x), bf_hi(G.a.x), bf_lo(G.a.y), bf_hi(G.a.y)};
    f32x4 kk = kx * kkc; const float nrm = sqrtf(hex_sum((kk.x * kk.x + kk.y * kk.y) + (kk.z * kk.z + kk.w * kk.w))); kk = kk * __builtin_amdgcn_rcpf(fmaxf(nrm, 1e-12f));
    const f32x4 k2 = kx * ((a - 1.0f) * kac + 1.0f);
    *(LAS f32x4*)(dst) = r; *(LAS f32x4*)(dst + 1024) = G.w; *(LAS f32x4*)(dst + 2048) = k2; *(LAS f32x4*)(dst + 3072) = v; *(LAS f32x4*)(dst + 4096) = -kk; *(LAS f32x4*)(dst + 5120) = kk * a;
}
__device__ __forceinline__ float rw_ysum(const LAS float* yp) { const LAS f32x4* q = (const LAS f32x4*)yp; const f32x4 a = q[0], b = q[1], c = q[2], d = q[3];
    return ((a.x + a.y) + (a.z + a.w)) + ((b.x + b.y) + (b.z + b.w)) + ((c.x + c.y) + (c.z + c.w)) + ((d.x + d.y) + (d.z + d.w)); }
#define RW_BAR() do { asm volatile("s_waitcnt lgkmcnt(0)" ::: "memory"); __builtin_amdgcn_s_barrier(); asm volatile("" ::: "memory"); } while (0)
__device__ __forceinline__ void rw_scan(LAS unsigned char* lds, const RwP& P, int unit, bf16_t* yraw) {
    const int tid = otid(), rq = unit & 3, bh = unit >> 2, b = bh >> 3, h = bh & 7, lane = tid & 63, wave = __builtin_amdgcn_readfirstlane(tid >> 6), hw = wave - 4, col = h * 64 + lane;
    LAS float* OP = (LAS float*)lds; LAS float* Y = OP + 2 * 6144;
    constexpr int NC = SEQ / 16;
    if (wave < 4) {
        const int cg = lane & 15, rl = 4 * wave + (lane >> 4), row = 16 * rq + rl;
        f32x2v S[2]; S[0] = (f32x2v){0.f, 0.f}; S[1] = (f32x2v){0.f, 0.f};
        RW_BAR();
        for (int c = 0; c < NC; ++c) {
            const LAS float* OPb = OP + (c & 1) * 6144; LAS float* Yb = Y + (c & 1) * 4096 + rl * 16 + cg;
            RwOps A, B;
            rw_ld(A, OPb, 0, cg, row);
#pragma unroll
            for (int t = 0; t < 16; t += 2) {
                rw_ld(B, OPb, t + 1, cg, row);
                Yb[t * 256] = rw_step(S, A);
                if (t + 2 < 16) rw_ld(A, OPb, t + 2, cg, row);
                Yb[(t + 1) * 256] = rw_step(S, B);
            }
            RW_BAR();
        }
        RW_BAR();
    } else {
        const int ht = tid - 256, yt = ht >> 4, yr = ht & 15, cq = lane & 15, pt = 4 * hw + (lane >> 4);
        const f32x4 kkc = *(const f32x4*)(P.k_k + h * 64 + 4 * cq), kac = *(const f32x4*)(P.k_a + h * 64 + 4 * cq);
        bf16_t* ydst = yraw + (size_t)(b * SEQ + yt) * 512 + h * 64 + 16 * rq + yr;
        const size_t ibase = (size_t)(b * SEQ + pt) * 512 + h * 64 + 4 * cq; const int poff = pt * 64 + 4 * cq;
        RwIn G0, G1, G2;
        rw_load_in(G0, P, ibase);
        rw_prep_chunk(G0, OP + poff, kkc, kac);
        rw_load_in(G1, P, ibase + (size_t)1 * 16 * 512);
        rw_load_in(G2, P, ibase + (size_t)2 * 16 * 512);
        RW_BAR();
#define RW_ITER(c_, GLD, GUSE) if ((c_) < NC) { const int cc_ = (c_), bf = cc_ & 1; \
            if (cc_ + 3 < NC) rw_load_in(GLD, P, ibase + (size_t)(cc_ + 3) * 16 * 512); \
            if (cc_ > 0) ydst[(size_t)(cc_ - 1) * 16 * 512] = (bf16_t)f2bf(rw_ysum(Y + (bf ^ 1) * 4096 + ht * 16)); \
            if (cc_ + 1 < NC) rw_prep_chunk(GUSE, OP + (bf ^ 1) * 6144 + poff, kkc, kac); \
            RW_BAR(); }
        for (int c = 0; c < NC; c += 3) { RW_ITER(c, G0, G1) RW_ITER(c + 1, G1, G2) RW_ITER(c + 2, G2, G0) }
#undef RW_ITER
        RW_BAR();
        ydst[(size_t)(NC - 1) * 16 * 512] = (bf16_t)f2bf(rw_ysum(Y + ((NC - 1) & 1) * 4096 + ht * 16));
    }
    __syncthreads();
}
#undef RW_BAR
__device__ __forceinline__ float oct_sum(float v) { v += dpp_f<0xB1>(v); v += dpp_f<0x4E>(v); v += dpp_f<0x141>(v); return v; }
__device__ __forceinline__ void rw_post_pass(const RwP& P, const bf16_t* yraw) {
    const int tid = otid(), lane = tid & 63, gw = blockIdx.x * 8 + (tid >> 6), NGW = gridDim.x * 8, c0 = 8 * lane;
    float ka[8], rk[8], lw[8], lb[8];
#pragma unroll
    for (int j = 0; j < 8; ++j) { ka[j] = P.k_a[c0 + j]; rk[j] = P.r_k[c0 + j]; lw[j] = P.ln_w[c0 + j]; lb[j] = P.ln_b[c0 + j]; }
#pragma unroll 4
    for (int m = gw; m < NT; m += NGW) { const size_t idx = (size_t)m * 512 + c0;
        float y[8], r[8], kx[8], v[8], a[8], g[8]; ld8(yraw + idx, y); ld8(P.xr + idx, r); ld8(P.xk + idx, kx); ld8(P.xv + idx, v); ld8(P.ab + idx, a); ld8(P.gb + idx, g);
        float sb = 0.f, sy = 0.f;
#pragma unroll
        for (int j = 0; j < 8; ++j) { const float k2 = kx[j] * (1.0f + (a[j] - 1.0f) * ka[j]); sb += r[j] * k2 * rk[j]; sy += y[j]; }
        const float bonus = oct_sum(sb), mean = oct_sum(sy) * (1.f / 64.f); float sv = 0.f;
#pragma unroll
        for (int j = 0; j < 8; ++j) { y[j] -= mean; sv += y[j] * y[j]; }
        const float rstd = rsqrtf(oct_sum(sv) * (1.f / 64.f) + 64e-5f); float o[8];
#pragma unroll
        for (int j = 0; j < 8; ++j) o[j] = (y[j] * rstd * lw[j] + lb[j] + bonus * v[j]) * g[j];
        u32x4 w; w.x = pk2(o[0], o[1]); w.y = pk2(o[2], o[3]); w.z = pk2(o[4], o[5]); w.w = pk2(o[6], o[7]);
        *(u32x4*)(P.ya + idx) = w; }
}

typedef short bf16x8_t __attribute__((ext_vector_type(8)));
typedef float f32x16 __attribute__((ext_vector_type(16)));
__device__ __forceinline__ bf16x8_t pack8(float a0, float a1, float a2, float a3, float a4, float a5, float a6, float a7) {
    u32x4 pz;
    asm volatile("s_nop 0\n\tv_cvt_pk_bf16_f32 %0, %4, %5\n\tv_cvt_pk_bf16_f32 %1, %6, %7\n\tv_cvt_pk_bf16_f32 %2, %8, %9\n\tv_cvt_pk_bf16_f32 %3, %10, %11\n\ts_nop 1"
                 : "=&v"(pz.x), "=&v"(pz.y), "=&v"(pz.z), "=&v"(pz.w) : "v"(a0), "v"(a1), "v"(a2), "v"(a3), "v"(a4), "v"(a5), "v"(a6), "v"(a7));
    return __builtin_bit_cast(bf16x8_t, pz); }
struct DilRaw { u32x4 k[4], v[4], q[2]; };
__device__ __forceinline__ void dil_load(const bf16_t* pdr, int unit, DilRaw& R) {
    const int tid = otid();
    const int rn = unit & 31, h = (unit >> 5) & 7, g = (unit >> 8) % 3, bl = unit / 768;
    const int ld = 2 * g, d = 1 << ld, rr = rn & (d - 1), n = rn >> ld;
    const int qcol = g * 1536 + h * 64, rowbase = bl * SEQ;
    const int row = tid >> 1, hf = tid & 1, mp = 128 * (n - 1) + row;
    if (mp >= 0) { const bf16_t* src = pdr + (size_t)(rowbase + mp * d + rr) * 6144 + qcol + hf * 32;
#pragma unroll
        for (int i = 0; i < 4; ++i) { R.k[i] = *(const u32x4*)(src + 512 + 8 * i); R.v[i] = *(const u32x4*)(src + 1024 + 8 * i); } }
    else {
#pragma unroll
        for (int i = 0; i < 4; ++i) { R.k[i] = (u32x4){0u, 0u, 0u, 0u}; R.v[i] = (u32x4){0u, 0u, 0u, 0u}; } }
    const int q = tid >> 2, p = tid & 3; const bf16_t* qs = pdr + (size_t)(rowbase + (128 * n + q) * d + rr) * 6144 + qcol + 16 * p;
    R.q[0] = *(const u32x4*)qs; R.q[1] = *(const u32x4*)(qs + 8);
}
__device__ __forceinline__ void up8(const u32x4 u, float* f) { f[0] = bf_lo(u.x); f[1] = bf_hi(u.x); f[2] = bf_lo(u.y); f[3] = bf_hi(u.y); f[4] = bf_lo(u.z); f[5] = bf_hi(u.z); f[6] = bf_lo(u.w); f[7] = bf_hi(u.w); }
__device__ __forceinline__ void dil_unit(LAS unsigned char* lds, const bf16_t* pdr, int unit, const DilRaw& R, int next_unit, DilRaw& Rn, const float* gq, const float* gk, const float* dcos, const float* dsin, bf16_t* og, float* deng) {
    const int tid = otid();
    const int rn = unit & 31, h = (unit >> 5) & 7, g = (unit >> 8) % 3, bl = unit / 768;
    const int ld = 2 * g, d = 1 << ld, rr = rn & (d - 1), n = rn >> ld;
    LAS bf16_t* Qs = (LAS bf16_t*)lds; LAS bf16_t* Ks = Qs + 128 * 72; LAS bf16_t* Vt = Ks + 256 * 72; LAS float* Xc = (LAS float*)(Vt + 64 * 260);
    const int qcol = g * 1536 + h * 64, rowbase = bl * SEQ;
    {   const int row = tid >> 1, hf = tid & 1, mp = 128 * (n - 1) + row;
        float kf[32];
        if (mp >= 0) { const int tk = mp * d + rr;
#pragma unroll
            for (int i = 0; i < 4; ++i) up8(R.k[i], kf + 8 * i);
            float ss = 0.f;
#pragma unroll
            for (int i = 0; i < 32; ++i) ss += kf[i] * kf[i];
            ss += __shfl_xor(ss, 1);
            const float rs = rsqrtf(ss * (1.f / 64.f) + 1e-6f);
#pragma unroll
            for (int i = 0; i < 32; ++i) kf[i] = kf[i] * rs * gk[g * 64 + hf * 32 + i];
            if (hf == 0) {
#pragma unroll
                for (int i = 0; i < 8; ++i) { const float c = dcos[tk * 8 + i], s = dsin[tk * 8 + i], x1 = kf[i], x2 = kf[i + 8]; kf[i] = x1 * c - x2 * s; kf[i + 8] = x2 * c + x1 * s; } }
        } else {
#pragma unroll
            for (int i = 0; i < 32; ++i) kf[i] = 0.f;
        }
#pragma unroll
        for (int i = 0; i < 4; ++i) { u32x4 w; w.x = pk2(kf[8 * i], kf[8 * i + 1]); w.y = pk2(kf[8 * i + 2], kf[8 * i + 3]); w.z = pk2(kf[8 * i + 4], kf[8 * i + 5]); w.w = pk2(kf[8 * i + 6], kf[8 * i + 7]);
            *(LAS u32x4*)(Ks + row * 72 + hf * 32 + 8 * i) = w; }
#pragma unroll
        for (int i = 0; i < 4; ++i) { const unsigned vv[4] = {R.v[i].x, R.v[i].y, R.v[i].z, R.v[i].w};
#pragma unroll
            for (int x = 0; x < 4; ++x) { Vt[(hf * 32 + 8 * i + 2 * x) * 260 + row] = (bf16_t)(vv[x] & 0xffffu); Vt[(hf * 32 + 8 * i + 2 * x + 1) * 260 + row] = (bf16_t)(vv[x] >> 16); } }
    }
    {   const int q = tid >> 2, p = tid & 3, tq = (128 * n + q) * d + rr;
        float qf[16]; up8(R.q[0], qf); up8(R.q[1], qf + 8);
        float ss = 0.f;
#pragma unroll
        for (int i = 0; i < 16; ++i) ss += qf[i] * qf[i];
        ss += __shfl_xor(ss, 1); ss += __shfl_xor(ss, 2);
        const float rs = rsqrtf(ss * (1.f / 64.f) + 1e-6f) * 0.125f;
#pragma unroll
        for (int i = 0; i < 16; ++i) qf[i] = qf[i] * rs * gq[g * 64 + 16 * p + i];
        if (p == 0) {
#pragma unroll
            for (int i = 0; i < 8; ++i) { const float c = dcos[tq * 8 + i], s = dsin[tq * 8 + i], x1 = qf[i], x2 = qf[i + 8]; qf[i] = x1 * c - x2 * s; qf[i + 8] = x2 * c + x1 * s; } }
#pragma unroll
        for (int i = 0; i < 2; ++i) { u32x4 w; w.x = pk2(qf[8 * i], qf[8 * i + 1]); w.y = pk2(qf[8 * i + 2], qf[8 * i + 3]); w.z = pk2(qf[8 * i + 4], qf[8 * i + 5]); w.w = pk2(qf[8 * i + 6], qf[8 * i + 7]);
            *(LAS u32x4*)(Qs + q * 72 + 16 * p + 8 * i) = w; }
    }
    __syncthreads();
    dil_load(pdr, next_unit, Rn);
    const int wv = __builtin_amdgcn_readfirstlane(tid >> 6), qt = wv & 3, kh = wv >> 2, lane = tid & 63, r = lane & 31, hh = lane >> 5;
    bf16x8_t qb[4];
#pragma unroll
    for (int ks = 0; ks < 4; ++ks) qb[ks] = *(const LAS bf16x8_t*)(Qs + (32 * qt + r) * 72 + 16 * ks + 8 * hh);
    f32x16 y0, y1; float den = 0.f;
#pragma unroll
    for (int i = 0; i < 16; ++i) { y0[i] = 0.f; y1[i] = 0.f; }
    const int qi = 32 * qt + r;
    for (int k4 = 0; k4 < 4; ++k4) { const int kt = 4 * kh + k4;
        if (kt < qt || kt > qt + 4) continue;
        f32x16 x;
#pragma unroll
        for (int i = 0; i < 16; ++i) x[i] = 0.f;
#pragma unroll
        for (int ks = 0; ks < 4; ++ks) { const bf16x8_t ka = *(const LAS bf16x8_t*)(Ks + (32 * kt + r) * 72 + 16 * ks + 8 * hh); x = __builtin_amdgcn_mfma_f32_32x32x16_bf16(ka, qb[ks], x, 0, 0, 0); }
#pragma unroll
        for (int i = 0; i < 16; ++i) { const int ki = 32 * kt + (i & 3) + 8 * (i >> 2) + 4 * hh;
            const bool valid = (ki >= qi) && (ki <= qi + 128) && (n > 0 || ki >= 128);
            const float e = valid ? __expf(x[i]) : 0.f; den += e; x[i] = e; }
#pragma unroll
        for (int s = 0; s < 2; ++s) { const bf16x8_t xs = pack8(x[8 * s], x[8 * s + 1], x[8 * s + 2], x[8 * s + 3], x[8 * s + 4], x[8 * s + 5], x[8 * s + 6], x[8 * s + 7]);
            const int kcol = 32 * kt + 16 * s + 4 * hh;
            {   const u32x2 lo = *(const LAS u32x2*)(Vt + r * 260 + kcol), hi = *(const LAS u32x2*)(Vt + r * 260 + kcol + 8); u32x4 v4; v4.x = lo.x; v4.y = lo.y; v4.z = hi.x; v4.w = hi.y;
                y0 = __builtin_amdgcn_mfma_f32_32x32x16_bf16(__builtin_bit_cast(bf16x8_t, v4), xs, y0, 0, 0, 0); }
            {   const u32x2 lo = *(const LAS u32x2*)(Vt + (32 + r) * 260 + kcol), hi = *(const LAS u32x2*)(Vt + (32 + r) * 260 + kcol + 8); u32x4 v4; v4.x = lo.x; v4.y = lo.y; v4.z = hi.x; v4.w = hi.y;
                y1 = __builtin_amdgcn_mfma_f32_32x32x16_bf16(__builtin_bit_cast(bf16x8_t, v4), xs, y1, 0, 0, 0); }
        }
    }
    den += __shfl_xor(den, 32);
    LAS float* xc = Xc + (qt * 64 + lane) * 33;
    if (kh == 1) {
#pragma unroll
        for (int i = 0; i < 16; ++i) { xc[i] = y0[i]; xc[16 + i] = y1[i]; }
        xc[32] = den; }
    __syncthreads();
    if (kh == 0) {
#pragma unroll
        for (int i = 0; i < 16; ++i) { y0[i] += xc[i]; y1[i] += xc[16 + i]; }
        den += xc[32];
        const float inv = 1.0f / den; const int tq = (128 * n + qi) * d + rr; const size_t orow = (size_t)g * CH + rowbase + tq;
        bf16_t* dst = og + orow * 512 + h * 64 + 4 * hh;
#pragma unroll
        for (int gI = 0; gI < 4; ++gI) { u32x2 w0, w1; w0.x = pk2(y0[4 * gI] * inv, y0[4 * gI + 1] * inv); w0.y = pk2(y0[4 * gI + 2] * inv, y0[4 * gI + 3] * inv);
            w1.x = pk2(y1[4 * gI] * inv, y1[4 * gI + 1] * inv); w1.y = pk2(y1[4 * gI + 2] * inv, y1[4 * gI + 3] * inv);
            *(u32x2*)(dst + 8 * gI) = w0; *(u32x2*)(dst + 32 + 8 * gI) = w1; }
        if (hh == 0) deng[orow * 8 + h] = den;
    }
    __syncthreads();
}
__device__ __forceinline__ void dil_combine(const bf16_t* og, const float* deng, bf16_t* yb  ) {
    const int NI = CH * 64;
#pragma unroll 4
    for (int it = blockIdx.x * 512 + otid(); it < NI; it += gridDim.x * 512) { const int tok = it >> 6, c8 = (it & 63) * 8, h = c8 >> 6;
        const float d0 = deng[(size_t)tok * 8 + h], d1 = deng[((size_t)CH + tok) * 8 + h], d2 = deng[((size_t)2 * CH + tok) * 8 + h]; const float inv = 1.0f / (d0 + d1 + d2);
        float a[8], b[8], c[8]; ld8(og + (size_t)tok * 512 + c8, a); ld8(og + ((size_t)CH + tok) * 512 + c8, b); ld8(og + ((size_t)2 * CH + tok) * 512 + c8, c);
        float o[8];
#pragma unroll
        for (int i = 0; i < 8; ++i) o[i] = (d0 * a[i] + d1 * b[i] + d2 * c[i]) * inv;
        u32x4 w; w.x = pk2(o[0], o[1]); w.y = pk2(o[2], o[3]); w.z = pk2(o[4], o[5]); w.w = pk2(o[6], o[7]);
        *(u32x4*)(yb + (size_t)tok * 512 + c8) = w; }
}

__device__ __forceinline__ void ret_load_k(const bf16_t* src  , int t, int qq, const float* rcos, const float* rsin, float scale, float* o1, float* o2) {
    float x1[8], x2[8]; ld8(src + 8 * qq, x1); ld8(src + 32 + 8 * qq, x2);
#pragma unroll
    for (int e = 0; e < 8; ++e) { const float c = rcos[t * 32 + 8 * qq + e], s = rsin[t * 32 + 8 * qq + e]; o1[e] = (x1[e] * c - x2[e] * s) * scale; o2[e] = (x2[e] * c + x1[e] * s) * scale; }
}
__device__ __forceinline__ void retA_unit(LAS unsigned char* lds, const bf16_t* pdr, int unit, const float* rcos, const float* rsin, float* kvst) {
    const int tid = otid(), c = unit & 31, h = (unit >> 5) & 3, bl = unit >> 7;
    const float lg = logf(1.0f - exp2f(-5.0f - (float)h));
    LAS float* Ks = (LAS float*)lds; LAS float* Vs = Ks + 128 * 64;
    {   const int row = tid >> 2, qq = tid & 3, t = c * 128 + row; const bf16_t* src = pdr + (size_t)(bl * SEQ + t) * 6144 + 4608;
        float o1[8], o2[8]; ret_load_k(src + 256 + h * 64, t, qq, rcos, rsin, 0.125f * __expf(lg * (float)(127 - row)), o1, o2);
#pragma unroll
        for (int e = 0; e < 8; ++e) { Ks[row * 64 + 8 * qq + e] = o1[e]; Ks[row * 64 + 32 + 8 * qq + e] = o2[e]; }
#pragma unroll
        for (int i = 0; i < 4; ++i) { float v[8]; ld8(src + 512 + h * 128 + 32 * qq + 8 * i, v);
            *(LAS f32x4*)(Vs + row * 128 + 32 * qq + 8 * i) = (f32x4){v[0], v[1], v[2], v[3]}; *(LAS f32x4*)(Vs + row * 128 + 32 * qq + 8 * i + 4) = (f32x4){v[4], v[5], v[6], v[7]}; }
    }
    __syncthreads();
    const int dd = tid >> 3, e0 = (tid & 7) * 16;
    f32x4 a0 = {0.f, 0.f, 0.f, 0.f}, a1 = a0, a2 = a0, a3 = a0;
    for (int j = 0; j < 128; ++j) { const float kd = Ks[j * 64 + dd]; const LAS f32x4* vr = (const LAS f32x4*)(Vs + j * 128 + e0);
        a0 += vr[0] * kd; a1 += vr[1] * kd; a2 += vr[2] * kd; a3 += vr[3] * kd; }
    float* dst = kvst + (size_t)unit * 8192 + dd * 128 + e0;
    *(f32x4*)dst = a0; *(f32x4*)(dst + 4) = a1; *(f32x4*)(dst + 8) = a2; *(f32x4*)(dst + 12) = a3;
    __syncthreads();
}
__device__ __forceinline__ void retC_unit(LAS unsigned char* lds, const bf16_t* pdr, int unit, const float* rcos, const float* rsin, const float* kvst, const float* gain, bf16_t* yc  ) {
    const int tid = otid(), lane = tid & 63, c = unit & 31, h = (unit >> 5) & 3, bl = unit >> 7;
    const float lg = logf(1.0f - exp2f(-5.0f - (float)h)), gC = __expf(lg * 128.0f);
    LAS bf16_t* Qs = (LAS bf16_t*)lds; LAS bf16_t* Ks = Qs + 128 * 72; LAS bf16_t* Vt = Ks + 128 * 72; LAS bf16_t* St = Vt + 128 * 132; LAS float* Xc = (LAS float*)(St + 128 * 72);
    {
        f32x4 s0 = {0.f, 0.f, 0.f, 0.f}, s1 = s0, s2 = s0, s3 = s0;
        const float* kp = kvst + (size_t)(unit - c) * 8192 + tid * 16;
        int cc = 0;
        for (; cc + 4 <= c; cc += 4) { f32x4 kq[4][4];
#pragma unroll
            for (int q = 0; q < 4; ++q) { const f32x4* k4 = (const f32x4*)(kp + (size_t)(cc + q) * 8192); kq[q][0] = k4[0]; kq[q][1] = k4[1]; kq[q][2] = k4[2]; kq[q][3] = k4[3]; }
#pragma unroll
            for (int q = 0; q < 4; ++q) { s0 = s0 * gC + kq[q][0]; s1 = s1 * gC + kq[q][1]; s2 = s2 * gC + kq[q][2]; s3 = s3 * gC + kq[q][3]; } }
        for (; cc < c; ++cc) { const f32x4* k4 = (const f32x4*)(kp + (size_t)cc * 8192); s0 = s0 * gC + k4[0]; s1 = s1 * gC + k4[1]; s2 = s2 * gC + k4[2]; s3 = s3 * gC + k4[3]; }
        const int dd = tid >> 3, e0 = (tid & 7) * 16; const float sv[16] = {s0.x, s0.y, s0.z, s0.w, s1.x, s1.y, s1.z, s1.w, s2.x, s2.y, s2.z, s2.w, s3.x, s3.y, s3.z, s3.w};
#pragma unroll
        for (int x = 0; x < 16; ++x) St[(e0 + x) * 72 + dd] = (bf16_t)f2bf(sv[x]);
        const int row = tid >> 2, qq = tid & 3, t = c * 128 + row; const bf16_t* src = pdr + (size_t)(bl * SEQ + t) * 6144 + 4608;
        float o1[8], o2[8];
        ret_load_k(src + 256 + h * 64, t, qq, rcos, rsin, 0.125f, o1, o2);
        *(LAS u32x4*)(Ks + row * 72 + 8 * qq) = (u32x4){pk2(o1[0], o1[1]), pk2(o1[2], o1[3]), pk2(o1[4], o1[5]), pk2(o1[6], o1[7])};
        *(LAS u32x4*)(Ks + row * 72 + 32 + 8 * qq) = (u32x4){pk2(o2[0], o2[1]), pk2(o2[2], o2[3]), pk2(o2[4], o2[5]), pk2(o2[6], o2[7])};
        ret_load_k(src + h * 64, t, qq, rcos, rsin, 1.0f, o1, o2);
        *(LAS u32x4*)(Qs + row * 72 + 8 * qq) = (u32x4){pk2(o1[0], o1[1]), pk2(o1[2], o1[3]), pk2(o1[4], o1[5]), pk2(o1[6], o1[7])};
        *(LAS u32x4*)(Qs + row * 72 + 32 + 8 * qq) = (u32x4){pk2(o2[0], o2[1]), pk2(o2[2], o2[3]), pk2(o2[4], o2[5]), pk2(o2[6], o2[7])};
#pragma unroll
        for (int i = 0; i < 4; ++i) { const u32x4 v = *(const u32x4*)(src + 512 + h * 128 + 32 * qq + 8 * i); const unsigned vv[4] = {v.x, v.y, v.z, v.w};
#pragma unroll
            for (int x = 0; x < 4; ++x) { Vt[(32 * qq + 8 * i + 2 * x) * 132 + row] = (bf16_t)(vv[x] & 0xffffu); Vt[(32 * qq + 8 * i + 2 * x + 1) * 132 + row] = (bf16_t)(vv[x] >> 16); } }
    }
    __syncthreads();
    const int wv = __builtin_amdgcn_readfirstlane(tid >> 6), qt = wv & 3, eh = wv >> 2, r = lane & 31, hh = lane >> 5, qi = 32 * qt + r;
    bf16x8_t qb[4], qc[4];
    {   const float qd = __expf(lg * (float)(qi + 1));
#pragma unroll
        for (int ks = 0; ks < 4; ++ks) { const u32x4 u = *(const LAS u32x4*)(Qs + qi * 72 + 16 * ks + 8 * hh); qb[ks] = __builtin_bit_cast(bf16x8_t, u);
            qc[ks] = pack8(bf_lo(u.x) * qd, bf_hi(u.x) * qd, bf_lo(u.y) * qd, bf_hi(u.y) * qd, bf_lo(u.z) * qd, bf_hi(u.z) * qd, bf_lo(u.w) * qd, bf_hi(u.w) * qd); }
    }
    f32x16 y0, y1;
#pragma unroll
    for (int i = 0; i < 16; ++i) { y0[i] = 0.f; y1[i] = 0.f; }
    const int er0 = (64 * eh + r) * 132, er1 = (64 * eh + 32 + r) * 132;
    for (int kt = 0; kt <= qt; ++kt) {
        f32x16 x;
#pragma unroll
        for (int i = 0; i < 16; ++i) x[i] = 0.f;
#pragma unroll
        for (int ks = 0; ks < 4; ++ks) { const bf16x8_t ka = *(const LAS bf16x8_t*)(Ks + (32 * kt + r) * 72 + 16 * ks + 8 * hh); x = __builtin_amdgcn_mfma_f32_32x32x16_bf16(ka, qb[ks], x, 0, 0, 0); }
#pragma unroll
        for (int i = 0; i < 16; ++i) { const int j = 32 * kt + (i & 3) + 8 * (i >> 2) + 4 * hh; x[i] = (j <= qi) ? x[i] * __expf(lg * (float)(qi - j)) : 0.f; }
#pragma unroll
        for (int s = 0; s < 2; ++s) { const bf16x8_t xs = pack8(x[8 * s], x[8 * s + 1], x[8 * s + 2], x[8 * s + 3], x[8 * s + 4], x[8 * s + 5], x[8 * s + 6], x[8 * s + 7]);
            const int kcol = 32 * kt + 16 * s + 4 * hh;
            {   const u32x2 lo = *(const LAS u32x2*)(Vt + er0 + kcol), hi = *(const LAS u32x2*)(Vt + er0 + kcol + 8); u32x4 v4; v4.x = lo.x; v4.y = lo.y; v4.z = hi.x; v4.w = hi.y;
                y0 = __builtin_amdgcn_mfma_f32_32x32x16_bf16(__builtin_bit_cast(bf16x8_t, v4), xs, y0, 0, 0, 0); }
            {   const u32x2 lo = *(const LAS u32x2*)(Vt + er1 + kcol), hi = *(const LAS u32x2*)(Vt + er1 + kcol + 8); u32x4 v4; v4.x = lo.x; v4.y = lo.y; v4.z = hi.x; v4.w = hi.y;
                y1 = __builtin_amdgcn_mfma_f32_32x32x16_bf16(__builtin_bit_cast(bf16x8_t, v4), xs, y1, 0, 0, 0); }
        }
    }
#pragma unroll
    for (int ks = 0; ks < 4; ++ks) {
        const bf16x8_t sa0 = *(const LAS bf16x8_t*)(St + (64 * eh + r) * 72 + 16 * ks + 8 * hh), sa1 = *(const LAS bf16x8_t*)(St + (64 * eh + 32 + r) * 72 + 16 * ks + 8 * hh);
        y0 = __builtin_amdgcn_mfma_f32_32x32x16_bf16(sa0, qc[ks], y0, 0, 0, 0); y1 = __builtin_amdgcn_mfma_f32_32x32x16_bf16(sa1, qc[ks], y1, 0, 0, 0); }
    float ss = 0.f;
#pragma unroll
    for (int i = 0; i < 16; ++i) ss += y0[i] * y0[i] + y1[i] * y1[i];
    ss += __shfl_xor(ss, 32);
    if (hh == 0) Xc[eh * 128 + qi] = ss;
    __syncthreads();
    const float rms = rsqrtf((Xc[qi] + Xc[128 + qi]) * (1.f / 128.f) + 1e-6f);
    const int t = c * 128 + qi; const bf16_t* gsrc = pdr + (size_t)(bl * SEQ + t) * 6144 + 4608 + 1024 + h * 128 + 64 * eh + 4 * hh;
    bf16_t* dst = yc + (size_t)(bl * SEQ + t) * 512 + h * 128 + 64 * eh + 4 * hh; const float* gn = gain + h * 128 + 64 * eh + 4 * hh;
#pragma unroll
    for (int gI = 0; gI < 4; ++gI) {
        {   const u32x2 gb = *(const u32x2*)(gsrc + 8 * gI); const f32x4 g4 = *(const f32x4*)(gn + 8 * gI); const float gv[4] = {bf_lo(gb.x), bf_hi(gb.x), bf_lo(gb.y), bf_hi(gb.y)}; float o[4];
#pragma unroll
            for (int x = 0; x < 4; ++x) o[x] = gv[x] * sigmoidf_(gv[x]) * (y0[4 * gI + x] * rms * g4[x]);
            u32x2 w; w.x = pk2(o[0], o[1]); w.y = pk2(o[2], o[3]); *(u32x2*)(dst + 8 * gI) = w; }
        {   const u32x2 gb = *(const u32x2*)(gsrc + 32 + 8 * gI); const f32x4 g4 = *(const f32x4*)(gn + 32 + 8 * gI); const float gv[4] = {bf_lo(gb.x), bf_hi(gb.x), bf_lo(gb.y), bf_hi(gb.y)}; float o[4];
#pragma unroll
            for (int x = 0; x < 4; ++x) o[x] = gv[x] * sigmoidf_(gv[x]) * (y1[4 * gI + x] * rms * g4[x]);
            u32x2 w; w.x = pk2(o[0], o[1]); w.y = pk2(o[2], o[3]); *(u32x2*)(dst + 32 + 8 * gI) = w; }
    }
    __syncthreads();
}

enum { I_X = 0, I_MEM, I_NORM_FFN1, I_FFN1_W13, I_FFN1_W2, I_NORM_MIX, I_W_IN, I_RW_MU, I_RW_W0, I_RW_W2, I_RW_A0, I_RW_A2, I_RW_G2, I_RW_KK, I_RW_KA, I_RW_RK, I_RW_LNW, I_RW_LNB,
       I_DIL_QN, I_DIL_KN, I_RET_NORM, I_WB_RWKV, I_WB_DIL, I_WB_RET, I_W_OUT, I_NORM_XA, I_NORM_MEM, I_XA_WQ, I_XA_WKV, I_XA_QN, I_XA_KN, I_XA_WO, I_NORM_FFN2, I_FFN2_W13, I_FFN2_W2, N_IN };
struct Args { const float* in[N_IN]; float* out; unsigned char* ws; };
typedef const float* fptr_t;
__device__ __forceinline__ fptr_t ld_in(int i) { const __attribute__((address_space(4))) fptr_t* p = (const __attribute__((address_space(4))) fptr_t*)__builtin_amdgcn_kernarg_segment_ptr(); asm volatile("" : "+s"(p)); return p[i]; }

#define XB_TMO      128
#define XB_XCNT(j)  (256  + 64 * (j))
#define XB_XSUB(j)  (1280 + 64 * (j))
#define XB_XGEN(j)  (2304 + 64 * (j))
#define XB_TOP      3328
#define XB_TOPGEN   3392
#define XCD_BAR_WORDS 3456
#define XB_SPIN_CAP (1u << 18)

__device__ __forceinline__ unsigned xb_ld(unsigned* p)              { return __hip_atomic_load(p, __ATOMIC_RELAXED, __HIP_MEMORY_SCOPE_AGENT); }
__device__ __forceinline__ unsigned xb_add(unsigned* p, unsigned v) { return __hip_atomic_fetch_add(p, v, __ATOMIC_RELAXED, __HIP_MEMORY_SCOPE_AGENT); }
__device__ __forceinline__ unsigned xb_xcc_id() { return (unsigned)__builtin_amdgcn_s_getreg((3 << 11) | 20) & 0xFu; }
#define XB_SPIN(cond, bar) do { unsigned _sp = 0; while (cond) { __builtin_amdgcn_s_sleep(1); \
    if ((++_sp & 255u) == 0u) { if (xb_ld(&(bar)[XB_TMO])) break; if (_sp > XB_SPIN_CAP) { atomicAdd(&(bar)[XB_TMO], 1u); break; } } } } while (0)

struct XcdBarrier {
    unsigned* bar; unsigned x;
    volatile LAS unsigned* st;
};

__device__ __forceinline__ XcdBarrier xcd_barrier_post(unsigned* bar, volatile LAS unsigned* st) {
    XcdBarrier b; b.bar = bar; b.x = xb_xcc_id(); b.st = st;
    if (threadIdx.x == 0) (void)xb_add(&bar[XB_XCNT(b.x)], 1u);
    return b;
}
__device__ __forceinline__ void xcd_barrier_complete(unsigned* bar, unsigned x, unsigned& nloc, unsigned& nx) {
    const unsigned G = gridDim.x * gridDim.y * gridDim.z;
    unsigned sum, cnt, mine, sp = 0u;
    for (;;) {
        sum = 0u; cnt = 0u; mine = 0u;
#pragma unroll
        for (unsigned j = 0; j < 16; ++j) { const unsigned c = xb_ld(&bar[XB_XCNT(j)]); sum += c; cnt += (c > 0u) ? 1u : 0u; mine = (j == x) ? c : mine; }
        if (sum == G) break;
        __builtin_amdgcn_s_sleep(1);
        if ((++sp & 255u) == 0u) { if (xb_ld(&bar[XB_TMO])) break; if (sp > XB_SPIN_CAP) { atomicAdd(&bar[XB_TMO], 1u); break; } }
    }
    nloc = mine > 0u ? mine : 1u; nx = cnt > 0u ? cnt : 1u;
}

__device__ __forceinline__ void xcd_barrier(const XcdBarrier& b) {
    asm volatile("s_waitcnt vmcnt(0)" ::: "memory");
    __syncthreads();
    if (threadIdx.x == 0) {
        unsigned* bar = b.bar;
        __builtin_amdgcn_s_waitcnt(0);
        unsigned nloc = b.st[0], nx = b.st[1];
        if (nloc == 0u) { xcd_barrier_complete(bar, b.x, nloc, nx); b.st[0] = nloc; b.st[1] = nx; }
        const unsigned old = xb_add(&bar[XB_XSUB(b.x)], 1u);
        const unsigned gen = old / nloc;
        if (old + 1u == (gen + 1u) * nloc) {
            __builtin_amdgcn_fence(__ATOMIC_RELEASE, "agent");
            asm volatile("s_waitcnt vmcnt(0)" ::: "memory");
            const unsigned og = xb_add(&bar[XB_TOP], 1u);
            const unsigned tg = og / nx;
            if (og + 1u == (tg + 1u) * nx) xb_add(&bar[XB_TOPGEN], 1u);
            else XB_SPIN(xb_ld(&bar[XB_TOPGEN]) == tg, bar);
            __builtin_amdgcn_fence(__ATOMIC_ACQUIRE, "agent");
            xb_add(&bar[XB_XGEN(b.x)], 1u);
            asm volatile("s_waitcnt vmcnt(0)" ::: "memory");
        } else {
            XB_SPIN(xb_ld(&bar[XB_XGEN(b.x)]) == gen, bar);
            __builtin_amdgcn_fence(__ATOMIC_ACQUIRE, "agent");
            asm volatile("s_waitcnt vmcnt(0)" ::: "memory");
        }
    }
    __syncthreads();
}

constexpr int XB_LDS_OFF = LDS_BYTES - 16;
__device__ __forceinline__ unsigned char* wsp(size_t off) { const __attribute__((address_space(4))) fptr_t* p = (const __attribute__((address_space(4))) fptr_t*)__builtin_amdgcn_kernarg_segment_ptr(); asm volatile("" : "+s"(p)); return (unsigned char*)p[N_IN + 1] + off; }
__device__ __forceinline__ float* ld_out() { const __attribute__((address_space(4))) fptr_t* p = (const __attribute__((address_space(4))) fptr_t*)__builtin_amdgcn_kernarg_segment_ptr(); asm volatile("" : "+s"(p)); return (float*)p[N_IN]; }
#define TP(mib) (wsp(WS_T + (size_t)(mib) * MiB))
#define WB ((bf16_t*)wsp(WS_WB))
#define KVB ((bf16_t*)wsp(WS_KV))
#define U ((bf16_t*)wsp(WS_U))
#define hbuf (ld_out())
#define dcos ((float*)wsp(WS_TAB))
#define dsin ((float*)wsp(WS_TAB) + SEQ * 8)
#define rcos ((float*)wsp(WS_TAB) + SEQ * 16)
#define rsin ((float*)wsp(WS_TAB) + SEQ * 48)
#define prw ((bf16_t*)TP(0))
#define xr ((bf16_t*)TP(114))
#define xk ((bf16_t*)TP(146))
#define xv ((bf16_t*)TP(178))
#define ap ((bf16_t*)TP(210))
#define decay ((float*)TP(0))
#define abuf ((bf16_t*)TP(64))
#define gbuf ((bf16_t*)TP(234))
#define ya ((bf16_t*)TP(266))
#define yb ((bf16_t*)TP(298))
#define yc ((bf16_t*)TP(330))
#define pdr ((bf16_t*)TP(0))
#define og ((bf16_t*)TP(192))
#define deng ((float*)TP(240))
#define kvst ((float*)TP(242))
#define Yb ((bf16_t*)TP(0))
#define part ((float*)TP(192))
#define Qh ((bf16_t*)TP(0))
#define rq ((float*)TP(64))
#define rs ((float*)TP(66))
#define Pm ((bf16_t*)TP(68))
#define Ob ((bf16_t*)TP(132))
#define FFA ((bf16_t*)TP(0))
__global__ void __launch_bounds__(512, 2) fwd_kernel(Args a) {
    extern __shared__ __attribute__((aligned(16))) unsigned char lds_raw[];
    LAS unsigned char* lds = (LAS unsigned char*)lds_raw;
    cg::grid_group grid = cg::this_grid();
    if (otid() < 4) ((LAS unsigned*)(lds + XB_LDS_OFF))[otid()] = 0u;
    __syncthreads();
    if (blockIdx.x == 0) for (int i = otid(); i < 4096; i += 512) ((unsigned*)wsp(0))[i] = 0u;
#define GSYNC() do { XcdBarrier b_; b_.bar = (unsigned*)wsp(0); b_.x = xb_xcc_id(); b_.st = (volatile LAS unsigned*)(lds + XB_LDS_OFF); xcd_barrier(b_); } while (0)
    const int G = gridDim.x, bx = blockIdx.x, GT = G * 512;
    const int vx = (G & 7) ? bx : (bx & 7) * (G >> 3) + (bx >> 3);
#define gtid (bx * 512 + otid())
#define lane (otid() & 63)
#define wave (otid() >> 6)

    for (int i = gtid; i < SEQ * 40; i += GT) {
        if (i < SEQ * 8) { const int t = i >> 3, k = i & 7; const float inv = powf(500000.0f, -(float)k / 8.0f); const float ang = (float)t * inv; dcos[i] = cosf(ang); dsin[i] = sinf(ang); }
        else { const int i2 = i - SEQ * 8, t = i2 >> 5, k = i2 & 31; const float inv = powf(10000.0f, -(float)k / 32.0f); const float ang = (float)t * inv; rcos[i2] = cosf(ang); rsin[i2] = sinf(ang); }
    }
    {   bf16_t* wkvt = (bf16_t*)TP(0);
        bf16_t* mn = (bf16_t*)TP(8);
        for (int l = 0; l < 2; ++l) {
            conv_job(lds, ld_in(I_XA_WKV) + (size_t)l * 1024 * 2048, 2048, 0, 2048, 1024, wkvt + (size_t)l * 2048 * 1024, 0, 0);
            norm_rows(ld_in(I_MEM), ld_in(I_NORM_MEM) + l * DM, mn + (size_t)l * 2048 * 1024, 2048);
        }
    }
    grid.sync();
    {   XcdBarrier b0 = xcd_barrier_post((unsigned*)wsp(0), (volatile LAS unsigned*)(lds + XB_LDS_OFF)); (void)b0; }
    {   bf16_t* wkvt = (bf16_t*)TP(0); bf16_t* mn = (bf16_t*)TP(8); float* kvraw = (float*)TP(330);
        for (int l = 0; l < 2; ++l) { EpiF32 E{kvraw + (size_t)l * 2048 * 2048, 2048}; run_gemm(lds, mn + (size_t)l * 2048 * 1024, wkvt + (size_t)l * 2048 * 1024, 2048, 2048, 1024, E); }
    }

    for (int l = 0; l < 2; ++l) {
        const float* hin = l == 0 ? ld_in(I_X) : hbuf;
        {   const float* w13a = ld_in(I_FFN1_W13) + (size_t)l * 1024 * 5632; const float* w2a = ld_in(I_FFN1_W2) + (size_t)l * 2816 * 1024;
            const float* w13b = ld_in(I_FFN2_W13) + (size_t)l * 1024 * 5632; const float* w2b = ld_in(I_FFN2_W2) + (size_t)l * 2816 * 1024;
            const float* win = ld_in(I_W_IN) + (size_t)l * 1024 * 11040;
            conv_job(lds, w13a, 5632, 0, 5632, 1024, WB + WO_W13A, 1, 0);
            conv_job(lds, w2a, 1024, 0, 1024, 2816, WB + WO_W2A, 0, 768);
            conv_job(lds, w13b, 5632, 0, 5632, 1024, WB + WO_W13B, 1, 128);
            conv_job(lds, w2b, 1024, 0, 1024, 2816, WB + WO_W2B, 0, 896);
            conv_job(lds, win, 11040, 0, 1824, 1024, WB + WO_RW, 0, 256);
            conv_job(lds, win, 11040, 1824, 6144, 1024, WB + WO_DR, 0, 1168);
            conv_job(lds, win, 11040, 7968, 3072, 1024, WB + WO_G, 0, 144);
            conv_job(lds, ld_in(I_WB_RWKV) + (size_t)l * 512 * 1024, 1024, 0, 1024, 512, WB + WO_BR, 0, 1680);
            conv_job(lds, ld_in(I_WB_DIL) + (size_t)l * 512 * 1024, 1024, 0, 1024, 512, WB + WO_BR + 1024 * 512, 0, 1936);
            conv_job(lds, ld_in(I_WB_RET) + (size_t)l * 512 * 1024, 1024, 0, 1024, 512, WB + WO_BR + 2 * 1024 * 512, 0, 144);
            conv_job(lds, ld_in(I_W_OUT) + (size_t)l * 1024 * 1024, 1024, 0, 1024, 1024, WB + WO_OUT, 0, 400);
            conv_job(lds, ld_in(I_XA_WQ) + (size_t)l * 1024 * 1024, 1024, 0, 1024, 1024, WB + WO_Q, 0, 912);
            conv_job(lds, ld_in(I_XA_WO) + (size_t)l * 1024 * 1024, 1024, 0, 1024, 1024, WB + WO_O, 0, 1424);
            { unsigned zz = 0u; asm volatile("" : "+v"(zz)); for (int i = gtid; i < 224 * 1024 / 8; i += GT) *((u32x4*)(WB + WO_RW + 1824 * 1024) + i) = (u32x4){zz, zz, zz, zz}; }
            const float* w2l = ld_in(I_RW_W2) + (size_t)l * 64 * 512; const float* a2l = ld_in(I_RW_A2) + (size_t)l * 64 * 512; const float* g2l = ld_in(I_RW_G2) + (size_t)l * 160 * 512;
            for (int i = gtid; i < 1536 * 384; i += GT) { const int n = i / 384, k = i - n * 384; float v = 0.f;
                if (n < 512) { if (k < 64) v = w2l[k * 512 + n]; }
                else if (n < 1024) { if (k >= 64 && k < 128) v = a2l[(k - 64) * 512 + n - 512]; }
                else { if (k >= 128 && k < 288) v = g2l[(k - 128) * 512 + n - 1024]; }
                WB[WO_LORA + i] = (bf16_t)f2bf(v); }
            norm_rows(hin, ld_in(I_NORM_FFN1) + l * DM, U, NT);
        }
        GSYNC();
        if (l == 0)
        {   const float* kvraw = (const float*)TP(330);
            for (int l = 0; l < 2; ++l) { const float* raw = kvraw + (size_t)l * 2048 * 2048; bf16_t* Kp = KVB + (size_t)l * 4 * 1024 * 1024; bf16_t* Vt = Kp + 2 * 1024 * 1024;
                const float* gq = ld_in(I_XA_QN) + l * 256; const float* gk = ld_in(I_XA_KN) + l * 256;
                for (int it = bx * 8 + wave; it < 2048 * 4; it += G * 8) { const int row = it >> 2, hd = it & 3, b = row >> 8, m = row & 255;
                    const f32x4 k4 = *(const f32x4*)(raw + (size_t)row * 2048 + hd * 256 + 4 * lane);
                    const float ss = wave_sum((k4.x * k4.x + k4.y * k4.y) + (k4.z * k4.z + k4.w * k4.w)); const float rk = rsqrtf(ss * (1.f / 256.f) + 1e-6f) * 0.0625f;
                    const f32x4 g1 = *(const f32x4*)(gq + 4 * lane), g2 = *(const f32x4*)(gk + 4 * lane);
                    u32x2 w; w.x = pk2(k4.x * rk * g1.x * g2.x, k4.y * rk * g1.y * g2.y); w.y = pk2(k4.z * rk * g1.z * g2.z, k4.w * rk * g1.w * g2.w);
                    *(u32x2*)(Kp + ((size_t)(hd * 8 + b) * 256 + m) * 256 + 4 * lane) = w; }
                for (int idx = gtid; idx < 2 * 1024 * 1024; idx += GT) { const int m = idx & 255, dd = (idx >> 8) & 255, hb = idx >> 16, hd = hb >> 3, b = hb & 7;
                    Vt[idx] = (bf16_t)f2bf(raw[(size_t)(b * 256 + m) * 2048 + 1024 + hd * 256 + dd]); }
            }
        }
        {   EpiSwiglu E{FFA}; run_gemm(lds, U, WB + WO_W13A, NT, 5632, 1024, E); }
        GSYNC();
        {   EpiResid E{hin, hbuf, 0.5f}; run_gemm(lds, FFA, WB + WO_W2A, NT, 1024, DFF, E); }
        GSYNC();
        norm_rows(hbuf, ld_in(I_NORM_MIX) + l * DM, U, NT);
        GSYNC();
        {   EpiStore E{prw, 1824, 1824, 0, 0}; run_gemm(lds, U, WB + WO_RW, NT, 2048, 1024, E); }
        GSYNC();
        rw_prep(prw, ld_in(I_RW_MU) + l * 1824, xr, xk, xv, ap);
        GSYNC();
        {   EpiLora<0> E0{decay, abuf, gbuf, ld_in(I_RW_W0) + l * 512, ld_in(I_RW_A0) + l * 512}; run_gemm(lds, ap, WB + WO_LORA, NT, 512, 384, E0);
            EpiLora<1> E1{decay, abuf, gbuf, ld_in(I_RW_W0) + l * 512, ld_in(I_RW_A0) + l * 512}; run_gemm(lds, ap, WB + WO_LORA + 512 * 384, NT, 512, 384, E1);
            EpiLora<2> E2{decay, abuf, gbuf, ld_in(I_RW_W0) + l * 512, ld_in(I_RW_A0) + l * 512}; run_gemm(lds, ap, WB + WO_LORA + 1024 * 384, NT, 512, 384, E2); }
        GSYNC();
        {   RwP P{xr, xk, xv, abuf, gbuf, decay, ld_in(I_RW_KK) + l * 512, ld_in(I_RW_KA) + l * 512, ld_in(I_RW_RK) + l * 512, ld_in(I_RW_LNW) + l * 512, ld_in(I_RW_LNB) + l * 512, ya};
            for (int u = bx; u < 256; u += G) { const int x = u & 7, i = u >> 3; rw_scan(lds, P, ((x * 8 + (i >> 2)) << 2) | (i & 3), yb); } }
        GSYNC();
        {   RwP P{xr, xk, xv, abuf, gbuf, decay, ld_in(I_RW_KK) + l * 512, ld_in(I_RW_KA) + l * 512, ld_in(I_RW_RK) + l * 512, ld_in(I_RW_LNW) + l * 512, ld_in(I_RW_LNB) + l * 512, ya};
            rw_post_pass(P, yb); }
        GSYNC();
        {
            for (int ck = 0; ck < 2; ++ck) {
                {   EpiStore E{pdr, 6144, 6144, 0, 0}; run_gemm(lds, U + (size_t)ck * CH * DM, WB + WO_DR, CH, 6144, 1024, E); }
                GSYNC();
                {   DilRaw Ra, Rb; dil_load(pdr, vx < 3072 ? vx : 0, Ra);
                    for (int u = vx; u < 3072 + 512; u += G) {
                        if (u < 3072) { const int nu = u + G; dil_unit(lds, pdr, u, Ra, nu < 3072 ? nu : u, Rb, ld_in(I_DIL_QN) + l * 192, ld_in(I_DIL_KN) + l * 192, dcos, dsin, og, deng); Ra = Rb; }
                        else retA_unit(lds, pdr, u - 3072, rcos, rsin, kvst);
                    } }
                GSYNC();
                for (int u = vx; u < 512; u += G) retC_unit(lds, pdr, u, rcos, rsin, kvst, ld_in(I_RET_NORM) + l * 512, yc + (size_t)ck * CH * 512);
                dil_combine(og, deng, yb + (size_t)ck * CH * 512);
                GSYNC();
            }
        }
        {   for (int b = 0; b < 3; ++b) { EpiStore E{Yb + (size_t)b * NT * DM, DM, DM, 0, 0}; run_gemm(lds, b == 0 ? ya : (b == 1 ? yb : yc), WB + WO_BR + (size_t)b * 1024 * 512, NT, 1024, 512, E); } }
        GSYNC();
        {   EpiGate E{Yb, part}; pg8::Gemm g{U, WB + WO_G, NT, 3072, 1024}; GateOrder S{G, bx}; pg8::gemm_phase<EpiGate, GateOrder, true, true>(lds, g, S, E); }
        GSYNC();
        {   EpiResid E{hbuf, hbuf, 1.0f}; run_gemm(lds, Yb, WB + WO_OUT, NT, 1024, 1024, E); }
        GSYNC();
        norm_rows(hbuf, ld_in(I_NORM_XA) + l * DM, U, NT);
        GSYNC();
        {   EpiStoreQ E{Qh, rq}; run_gemm(lds, U, WB + WO_Q, NT, 1024, 1024, E); }
        GSYNC();
        {   const bf16_t* Kp = KVB + (size_t)l * 4 * 1024 * 1024; EpiScore E{Pm, rq, rs}; pg8::Gemm g{Qh, Kp, 4 * NT, 256, 256}; DiagOrder S{G, bx};
            pg8::gemm_phase<EpiScore, DiagOrder, true, true>(lds, g, S, E); }
        GSYNC();
        {   const bf16_t* Vt = KVB + (size_t)l * 4 * 1024 * 1024 + 2 * 1024 * 1024; EpiPV E{Ob, rs}; pg8::Gemm g{Pm, Vt, 4 * NT, 256, 256}; DiagOrder S{G, bx};
            pg8::gemm_phase<EpiPV, DiagOrder, true, true>(lds, g, S, E); }
        GSYNC();
        {   EpiResid E{hbuf, hbuf, 1.0f}; run_gemm(lds, Ob, WB + WO_O, NT, 1024, 1024, E); }
        GSYNC();
        norm_rows(hbuf, ld_in(I_NORM_FFN2) + l * DM, U, NT);
        GSYNC();
        {   EpiSwiglu E{FFA}; run_gemm(lds, U, WB + WO_W13B, NT, 5632, 1024, E); }
        GSYNC();
        {   EpiResid E{hbuf, hbuf, 0.5f}; run_gemm(lds, FFA, WB + WO_W2B, NT, 1024, DFF, E); }
        if (l == 0) GSYNC();
    }
}

#undef prw
#undef xr
#undef xk
#undef xv
#undef ap
#undef decay
#undef abuf
#undef gbuf
#undef ya
#undef yb
#undef yc
#undef pdr
#undef og
#undef deng
#undef kvst
#undef Yb
#undef part
#undef Qh
#undef rq
#undef rs
#undef Pm
#undef Ob
#undef FFA
#undef gtid
#undef lane
#undef wave
#undef TP
#undef WB
#undef KVB
#undef U
#undef hbuf
#undef dcos
#undef dsin
#undef rcos
#undef rsin
extern "C" void kernel_launch(void* const* d_in, const int* in_sizes, int n_in, void* d_out, int out_size, void* d_ws, size_t ws_size, hipStream_t stream) {
    static int grid = 0;
    if (grid == 0) {
        if (n_in != N_IN || ws_size < WS_END) { fprintf(stderr, "kernel_launch: unexpected n_in %d / ws_size %zu (need %zu)\n", n_in, ws_size, (size_t)WS_END); grid = -1; return; }
        int dev = 0, cus = 0, per_cu = 0;
        (void)hipGetDevice(&dev);
        (void)hipDeviceGetAttribute(&cus, hipDeviceAttributeMultiprocessorCount, dev);
        (void)hipFuncSetAttribute((const void*)fwd_kernel, hipFuncAttributeMaxDynamicSharedMemorySize, LDS_BYTES);
        (void)hipOccupancyMaxActiveBlocksPerMultiprocessor(&per_cu, (const void*)fwd_kernel, 512, LDS_BYTES);
        if (per_cu < 1) per_cu = 1;
        grid = cus * per_cu;
    }
    if (grid < 0) return;
    Args a{};
    for (int i = 0; i < N_IN; ++i) a.in[i] = (const float*)d_in[i];
    a.out = (float*)d_out; a.ws = (unsigned char*)d_ws;
    void* args[] = {&a};
    hipError_t e = hipLaunchCooperativeKernel((void*)fwd_kernel, dim3(grid), dim3(512), args, LDS_BYTES, stream);
    if (e != hipSuccess) fprintf(stderr, "cooperative launch failed: %s (grid %d)\n", hipGetErrorString(e), grid);
}
```
